# Optimizing an MI355X kernel written in HIP

```python
import math
import jax, jax.numpy as jnp
from jax import lax
import numpy as np

D_MODEL = 1024
BATCH = 2
SEQ = 8192
DEPTH = 2

HEAD_DIM = 64
MEM_LEN = 256
MEM_HEADS = 4
MEM_WIDTH = MEM_HEADS * HEAD_DIM
MIX_WIDTH = D_MODEL
CONV_CH = MIX_WIDTH - MEM_WIDTH
CONV_WIDTH = 31
SWA_Q_HEADS = 12
SWA_KV_HEADS = 4
SWA_GROUP = SWA_Q_HEADS // SWA_KV_HEADS
SWA_Q_WIDTH = SWA_Q_HEADS * HEAD_DIM
SWA_KV_WIDTH = SWA_KV_HEADS * HEAD_DIM
WINDOW = 128
BLOCK = 128
D_FF_DENSE = 2816
N_EXPERTS = 8
TOP_K = 2
D_FF_EXPERT = 3584
N_EVEN = (DEPTH + 1) // 2
N_ODD = DEPTH // 2
RMS_EPS = 1e-6
LN_EPS = 1e-5
ALIBI_MAX_BIAS = 8.0
NEG_INF = -1e30

kernel_name = "hybrid_conformer_swa_alibi_mem_moe"


def rms_norm(x, g):
    xf = x.astype(jnp.float32)
    y = xf * lax.rsqrt(jnp.mean(xf * xf, axis=-1, keepdims=True) + RMS_EPS)
    return (y * g.astype(jnp.float32)).astype(x.dtype)


def layer_norm(x, g, b):
    xf = x.astype(jnp.float32)
    mu = jnp.mean(xf, axis=-1, keepdims=True)
    var = jnp.mean(jnp.square(xf - mu), axis=-1, keepdims=True)
    y = (xf - mu) * lax.rsqrt(var + LN_EPS)
    return (y * g.astype(jnp.float32) + b.astype(jnp.float32)).astype(x.dtype)


def swiglu(h, w_gate, w_up, w_down):
    return (jax.nn.silu(h @ w_gate) * (h @ w_up)) @ w_down


def alibi_slopes(n_heads):
    return jnp.exp2(-ALIBI_MAX_BIAS * (jnp.arange(n_heads, dtype=jnp.float32) + 1.0) / n_heads)


def memory_attention(q, q_g, mem_k, mem_v):
    b, s, _ = q.shape
    q = rms_norm(q.reshape(b, s, MEM_HEADS, HEAD_DIM), q_g)
    sc = jnp.einsum('bshd,bmhd->bhsm', q, mem_k).astype(jnp.float32) * (HEAD_DIM ** -0.5)
    p = jax.nn.softmax(sc, axis=-1).astype(mem_v.dtype)
    o = jnp.einsum('bhsm,bmhd->bshd', p, mem_v)
    return o.reshape(b, s, MEM_WIDTH)


def conv_mixer(h, w_in, b_glu, dw_w, dw_b, ln_g, ln_b, memq_g, w_out, mem_k, mem_v):
    proj = h @ w_in
    a = proj[..., :CONV_CH] + b_glu[:CONV_CH]
    gate = proj[..., CONV_CH:2 * CONV_CH] + b_glu[CONV_CH:]
    q_mem = proj[..., 2 * CONV_CH:]
    u = a * jax.nn.sigmoid(gate)
    u_pad = jnp.pad(u, ((0, 0), (CONV_WIDTH - 1, 0), (0, 0)))
    c = lax.conv_general_dilated(
        u_pad, dw_w[:, None, :], window_strides=(1,), padding='VALID',
        dimension_numbers=('NWC', 'WIO', 'NWC'), feature_group_count=CONV_CH) + dw_b
    c = jax.nn.silu(layer_norm(c, ln_g, ln_b))
    m = memory_attention(q_mem, memq_g, mem_k, mem_v)
    return jnp.concatenate([c, m], axis=-1) @ w_out


def swa_mixer(h, w_in, q_g, k_g, sinks, memq_g, w_out, mem_k, mem_v):
    b, s, _ = h.shape
    nb = s // BLOCK
    proj = h @ w_in
    o1 = SWA_Q_WIDTH
    o2 = o1 + SWA_KV_WIDTH
    o3 = o2 + SWA_KV_WIDTH
    q = rms_norm(proj[..., :o1].reshape(b, s, SWA_KV_HEADS, SWA_GROUP, HEAD_DIM), q_g)
    k = rms_norm(proj[..., o1:o2].reshape(b, s, SWA_KV_HEADS, HEAD_DIM), k_g)
    v = proj[..., o2:o3].reshape(b, s, SWA_KV_HEADS, HEAD_DIM)
    q_mem = proj[..., o3:]

    qb = q.reshape(b, nb, BLOCK, SWA_KV_HEADS, SWA_GROUP, HEAD_DIM)
    def band(t):
        prev = jnp.pad(t, ((0, 0), (BLOCK, 0), (0, 0), (0, 0)))[:, :s]
        return jnp.concatenate([prev.reshape(b, nb, BLOCK, SWA_KV_HEADS, HEAD_DIM),
                                t.reshape(b, nb, BLOCK, SWA_KV_HEADS, HEAD_DIM)], axis=2)
    kk = band(k)
    vv = band(v)
    sc = jnp.einsum('bnqhgd,bnchd->bnhgqc', qb, kk).astype(jnp.float32) * (HEAD_DIM ** -0.5)

    qpos = jnp.arange(BLOCK) + BLOCK
    kpos = jnp.arange(2 * BLOCK)
    dist = (qpos[:, None] - kpos[None, :]).astype(jnp.float32)
    win = (dist >= 0) & (dist < WINDOW)
    first = (jnp.arange(nb)[:, None] > 0) | (kpos[None, :] >= BLOCK)
    mask = win[None, :, :] & first[:, None, :]
    slopes = alibi_slopes(SWA_Q_HEADS).reshape(SWA_KV_HEADS, SWA_GROUP)
    bias = -slopes[:, :, None, None] * dist[None, None]
    sc = jnp.where(mask[None, :, None, None], sc + bias[None, None], NEG_INF)

    sink = jnp.broadcast_to(sinks.astype(jnp.float32).reshape(1, 1, SWA_KV_HEADS, SWA_GROUP, 1, 1),
                            sc.shape[:-1] + (1,))
    p = jax.nn.softmax(jnp.concatenate([sc, sink], axis=-1), axis=-1)[..., :-1]
    o = jnp.einsum('bnhgqc,bnchd->bnqhgd', p.astype(vv.dtype), vv).reshape(b, s, SWA_Q_WIDTH)
    m = memory_attention(q_mem, memq_g, mem_k, mem_v)
    return jnp.concatenate([o, m], axis=-1) @ w_out


def moe_swiglu(h, router, we_gate, we_up, we_down):
    logits = (h @ router).astype(jnp.float32)
    top_v, top_i = lax.top_k(logits, TOP_K)
    top_w = jax.nn.softmax(top_v, axis=-1)
    gates = jnp.sum(jax.nn.one_hot(top_i, N_EXPERTS, dtype=jnp.float32) * top_w[..., None], axis=-2)
    gates = gates.astype(h.dtype)
    out = jnp.zeros_like(h)
    for e in range(N_EXPERTS):
        out = out + gates[..., e:e + 1] * swiglu(h, we_gate[e], we_up[e], we_down[e])
    return out


def setup_inputs(seed: int = 0) -> dict:
    key = jax.random.key(seed)
    ks = iter(jax.random.split(key, 40))
    f32 = jnp.float32
    def nrm(shape, scale):
        return jax.random.normal(next(ks), shape, f32) * scale
    def gain(shape):
        return 1.0 + 0.05 * jax.random.normal(next(ks), shape, f32)
    D = D_MODEL
    return {
        "x": nrm((BATCH, SEQ, D), 1.0),
        "mem": nrm((BATCH, MEM_LEN, D), 1.0),
        "mem_norm_g": gain((D,)),
        "w_mem_kv": nrm((D, 2 * MEM_WIDTH), D ** -0.5),
        "mem_k_norm_g": gain((HEAD_DIM,)),
        "cv_attn_norm_g": gain((N_EVEN, D)),
        "cv_w_in": nrm((N_EVEN, D, 2 * CONV_CH + MEM_WIDTH), D ** -0.5),
        "cv_b_glu": nrm((N_EVEN, 2 * CONV_CH), 0.02),
        "cv_dw_w": nrm((N_EVEN, CONV_WIDTH, CONV_CH), CONV_WIDTH ** -0.5),
        "cv_dw_b": nrm((N_EVEN, CONV_CH), 0.02),
        "cv_ln_g": gain((N_EVEN, CONV_CH)),
        "cv_ln_b": nrm((N_EVEN, CONV_CH), 0.02),
        "cv_memq_norm_g": gain((N_EVEN, HEAD_DIM)),
        "cv_w_out": nrm((N_EVEN, MIX_WIDTH, D), MIX_WIDTH ** -0.5),
        "cv_ffn_norm_g": gain((N_EVEN, D)),
        "cv_w_gate": nrm((N_EVEN, D, D_FF_DENSE), D ** -0.5),
        "cv_w_up": nrm((N_EVEN, D, D_FF_DENSE), D ** -0.5),
        "cv_w_down": nrm((N_EVEN, D_FF_DENSE, D), D_FF_DENSE ** -0.5),
        "sw_attn_norm_g": gain((N_ODD, D)),
        "sw_w_in": nrm((N_ODD, D, SWA_Q_WIDTH + 2 * SWA_KV_WIDTH + MEM_WIDTH), D ** -0.5),
        "sw_q_norm_g": gain((N_ODD, HEAD_DIM)),
        "sw_k_norm_g": gain((N_ODD, HEAD_DIM)),
        "sw_sinks": nrm((N_ODD, SWA_Q_HEADS), 0.5),
        "sw_memq_norm_g": gain((N_ODD, HEAD_DIM)),
        "sw_w_out": nrm((N_ODD, MIX_WIDTH, D), MIX_WIDTH ** -0.5),
        "sw_ffn_norm_g": gain((N_ODD, D)),
        "sw_router": nrm((N_ODD, D, N_EXPERTS), D ** -0.5),
        "sw_we_gate": nrm((N_ODD, N_EXPERTS, D, D_FF_EXPERT), D ** -0.5),
        "sw_we_up": nrm((N_ODD, N_EXPERTS, D, D_FF_EXPERT), D ** -0.5),
        "sw_we_down": nrm((N_ODD, N_EXPERTS, D_FF_EXPERT, D), D_FF_EXPERT ** -0.5),
    }


def reference(x, mem, mem_norm_g, w_mem_kv, mem_k_norm_g,
              cv_attn_norm_g, cv_w_in, cv_b_glu, cv_dw_w, cv_dw_b, cv_ln_g, cv_ln_b,
              cv_memq_norm_g, cv_w_out, cv_ffn_norm_g, cv_w_gate, cv_w_up, cv_w_down,
              sw_attn_norm_g, sw_w_in, sw_q_norm_g, sw_k_norm_g, sw_sinks, sw_memq_norm_g,
              sw_w_out, sw_ffn_norm_g, sw_router, sw_we_gate, sw_we_up, sw_we_down):
    b, m_len, _ = mem.shape
    mkv = rms_norm(mem, mem_norm_g) @ w_mem_kv
    mem_k = rms_norm(mkv[..., :MEM_WIDTH].reshape(b, m_len, MEM_HEADS, HEAD_DIM), mem_k_norm_g)
    mem_v = mkv[..., MEM_WIDTH:].reshape(b, m_len, MEM_HEADS, HEAD_DIM)

    h = x
    for i in range(DEPTH):
        j = i // 2
        if i % 2 == 0:
            hn = rms_norm(h, cv_attn_norm_g[j])
            h = h + conv_mixer(hn, cv_w_in[j], cv_b_glu[j], cv_dw_w[j], cv_dw_b[j], cv_ln_g[j],
                               cv_ln_b[j], cv_memq_norm_g[j], cv_w_out[j], mem_k, mem_v)
            hn = rms_norm(h, cv_ffn_norm_g[j])
            h = h + swiglu(hn, cv_w_gate[j], cv_w_up[j], cv_w_down[j])
        else:
            hn = rms_norm(h, sw_attn_norm_g[j])
            h = h + swa_mixer(hn, sw_w_in[j], sw_q_norm_g[j], sw_k_norm_g[j], sw_sinks[j],
                              sw_memq_norm_g[j], sw_w_out[j], mem_k, mem_v)
            hn = rms_norm(h, sw_ffn_norm_g[j])
            h = h + moe_swiglu(hn, sw_router[j], sw_we_gate[j], sw_we_up[j], sw_we_down[j])
    return h
```

```cpp
#include <hip/hip_runtime.h>
#include <cstdio>
#include <cstdint>

#ifndef MK_PER_PHASE
#define MK_PER_PHASE 0
#endif
#ifndef PROBE_REPEAT_MASK
#define PROBE_REPEAT_MASK 0
#endif

#define GAS __attribute__((address_space(1)))
#define LAS __attribute__((address_space(3)))
typedef unsigned short bf16;
typedef unsigned short bf16_t;
typedef short bf16x8 __attribute__((ext_vector_type(8)));
typedef short s16x4 __attribute__((ext_vector_type(4)));
typedef float f32x4 __attribute__((ext_vector_type(4)));
typedef float f32x2 __attribute__((ext_vector_type(2)));
typedef unsigned u32x4 __attribute__((ext_vector_type(4)));
typedef unsigned u32x2 __attribute__((ext_vector_type(2)));
typedef GAS unsigned gu32;

constexpr int BATCH = 2, SEQ = 8192, M = BATCH * SEQ, D = 1024;
constexpr int CONV_CH = 768, CONV_W = 31, MEMW = 256, HD = 64;
constexpr int N_IN0 = 2 * CONV_CH + MEMW;
constexpr int N_IN1 = 768 + 256 + 256 + 256;
constexpr int FF = 2816, NE = 8, FE = 3584;
constexpr int MEM_LEN = 256, MEM_ROWS = BATCH * MEM_LEN;
constexpr int P0_ROWS = 80 * 256;
constexpr int P1_ROWS = 64 * 256;
constexpr int TOK_ATOMIC = 0x40000000;
constexpr float RMS_EPS = 1e-6f, LN_EPS = 1e-5f;
constexpr float LOG2E = 1.4426950408889634f;
constexpr float QSCALE = 0.125f * LOG2E;
constexpr float S_X = 16.0f, S_W = 1024.0f, S_A = 8.0f, S_WD = 2048.0f;

constexpr size_t MiB = 1u << 20;
constexpr size_t WS_CTL = 0, CTL_ZERO_BYTES = 1 * MiB;
constexpr size_t WS_WIN0 = 1 * MiB;
constexpr size_t WS_WOUT0 = WS_WIN0 + (size_t)N_IN0 * D * 2;
constexpr size_t WS_WGU0 = WS_WOUT0 + (size_t)D * D * 2;
constexpr size_t WS_WDN0 = WS_WGU0 + (size_t)2 * FF * D * 2;
constexpr size_t WS_WIN1 = WS_WDN0 + (size_t)D * FF * 2;
constexpr size_t WS_WOUT1 = WS_WIN1 + (size_t)N_IN1 * D * 2;
constexpr size_t WS_WMKV = WS_WOUT1 + (size_t)D * D * 2;
constexpr size_t WS_MEMB = WS_WMKV + (size_t)512 * D * 2;
constexpr size_t WS_MEMK = WS_MEMB + (size_t)MEM_ROWS * D * 2;
constexpr size_t WS_MEMV = WS_MEMK + (size_t)MEM_ROWS * 256 * 2;
constexpr size_t WS_SSQM = WS_MEMV + (size_t)MEM_ROWS * 256 * 2;
constexpr size_t WS_SSQ = 31 * MiB;
constexpr size_t WS_WGUE = 32 * MiB;
constexpr size_t WS_WDNE = 88 * MiB;
constexpr size_t WS_HB = 200 * MiB;
constexpr size_t WS_H = 232 * MiB;
constexpr size_t WS_PROJ = 296 * MiB;
constexpr size_t WS_MIX = 344 * MiB;
constexpr size_t WS_ACT0 = 296 * MiB;
constexpr size_t WS_ACTE = 232 * MiB;
constexpr size_t WS_XS = 358 * MiB;
constexpr size_t WS_ROUTE = 430 * MiB;
constexpr size_t WS_END = 432 * MiB;
static_assert(WS_SSQM + MEM_ROWS * 16 * 4 <= WS_SSQ && WS_ACT0 + (size_t)M * FF * 2 <= WS_XS + 72 * MiB, "ws map");
static_assert(WS_ACTE + (size_t)(P0_ROWS + P1_ROWS) * FE <= WS_XS && WS_XS + (size_t)(P0_ROWS + P1_ROWS) * D <= WS_ROUTE, "ws map moe");
constexpr size_t PJ_U = WS_PROJ, PJ_QM0 = WS_PROJ + (size_t)M * 768 * 2;
constexpr size_t PJ_Q = WS_PROJ, PJ_K = PJ_Q + (size_t)M * 768 * 2, PJ_V = PJ_K + (size_t)M * 256 * 2, PJ_QM1 = PJ_V + (size_t)M * 256 * 2;
constexpr size_t RT_TOKE = WS_ROUTE;
constexpr size_t RT_TOKS = RT_TOKE + 2 * M * 4;
constexpr size_t RT_TOKW = RT_TOKS + 2 * M * 4;
constexpr size_t RT_TOKR = RT_TOKW + 2 * M * 4;
constexpr size_t RT_ROWTOK = RT_TOKR + M * 4;
constexpr size_t RT_ROWG = RT_ROWTOK + (P0_ROWS + P1_ROWS) * 4;
static_assert(RT_ROWG + (P0_ROWS + P1_ROWS) * 4 <= WS_ROUTE + MiB, "route map");
constexpr int CW_TMO = 0, CW_CODE = 1, CW_BAR = 4096, CW_CNT = 8192;
constexpr int CW_STEAL = 16384, CW_DONE = 16448;

constexpr int RING_BYTES = 131072;
constexpr int LDSCTL_OFF = RING_BYTES, MISC_OFF = LDSCTL_OFF + 320;
constexpr int LDS_BYTES = 147456;
constexpr int NWAVES = 8;

#define RLX_AGENT __ATOMIC_RELAXED, __HIP_MEMORY_SCOPE_AGENT
#define LDS_WAIT() asm volatile("s_waitcnt lgkmcnt(0)" ::: "memory")
#define VM_WAIT() asm volatile("s_waitcnt vmcnt(0)" ::: "memory")

__device__ __forceinline__ unsigned f2bf(float f) { unsigned u = __builtin_bit_cast(unsigned, f); return (u + 0x7fffu + ((u >> 16) & 1u)) >> 16; }
__device__ __forceinline__ unsigned pk2(float lo, float hi) { return f2bf(lo) | (f2bf(hi) << 16); }
__device__ __forceinline__ unsigned cvt_pk_bf16(float lo, float hi) { unsigned r; asm volatile("v_cvt_pk_bf16_f32 %0, %1, %2" : "=v"(r) : "v"(lo), "v"(hi)); return r; }
__device__ __forceinline__ unsigned pk4_fp8(float a, float b, float c, float d) { int r = 0; r = __builtin_amdgcn_cvt_pk_fp8_f32(a, b, r, false); r = __builtin_amdgcn_cvt_pk_fp8_f32(c, d, r, true); return (unsigned)r; }
__device__ __forceinline__ float bf_lo(unsigned v) { return __builtin_bit_cast(float, v << 16); }
__device__ __forceinline__ float bf_hi(unsigned v) { return __builtin_bit_cast(float, v & 0xffff0000u); }
__device__ __forceinline__ float sigmoidf_fast(float g) { return __builtin_amdgcn_rcpf(1.0f + __builtin_amdgcn_exp2f(-LOG2E * g)); }
__device__ __forceinline__ float wave_sum(float v) {
#pragma unroll
    for (int o = 1; o < 64; o <<= 1) v += __shfl_xor(v, o);
    return v;
}

#define XB_TMO      128
#define XB_XCNT(j)  (256  + 64 * (j))
#define XB_XSUB(j)  (1280 + 64 * (j))
#define XB_XGEN(j)  (2304 + 64 * (j))
#define XB_TOP      3328
#define XB_TOPGEN   3392
#define XCD_BAR_WORDS 3456
#define XB_SPIN_CAP (1u << 18)
__device__ __forceinline__ unsigned xb_ld(unsigned* p)              { return __hip_atomic_load(p, __ATOMIC_RELAXED, __HIP_MEMORY_SCOPE_AGENT); }
__device__ __forceinline__ unsigned xb_add(unsigned* p, unsigned v) { return __hip_atomic_fetch_add(p, v, __ATOMIC_RELAXED, __HIP_MEMORY_SCOPE_AGENT); }
__device__ __forceinline__ unsigned xb_xcc_id() { return (unsigned)__builtin_amdgcn_s_getreg((3 << 11) | 20) & 0xFu; }
#define XB_SPIN(cond, bar) do { unsigned _sp = 0; while (cond) { __builtin_amdgcn_s_sleep(1); \
    if ((++_sp & 255u) == 0u) { if (xb_ld(&(bar)[XB_TMO])) break; if (_sp > XB_SPIN_CAP) { atomicAdd(&(bar)[XB_TMO], 1u); break; } } } } while (0)
struct XcdBarrier { unsigned* bar; unsigned x; volatile LAS unsigned* st; };
__device__ __forceinline__ XcdBarrier xcd_barrier_post(unsigned* bar, volatile LAS unsigned* st) {
    XcdBarrier b; b.bar = bar; b.x = xb_xcc_id(); b.st = st;
    if (threadIdx.x == 0) (void)xb_add(&bar[XB_XCNT(b.x)], 1u);
    return b;
}
__device__ __forceinline__ void xcd_barrier_complete(unsigned* bar, unsigned x, unsigned& nloc, unsigned& nx) {
    const unsigned G = gridDim.x * gridDim.y * gridDim.z;
    unsigned sum, cnt, mine, sp = 0u;
    for (;;) {
        sum = 0u; cnt = 0u; mine = 0u;
#pragma unroll
        for (unsigned j = 0; j < 16; ++j) { const unsigned c = xb_ld(&bar[XB_XCNT(j)]); sum += c; cnt += (c > 0u) ? 1u : 0u; mine = (j == x) ? c : mine; }
        if (sum == G) break;
        __builtin_amdgcn_s_sleep(1);
        if ((++sp & 255u) == 0u) { if (xb_ld(&bar[XB_TMO])) break; if (sp > XB_SPIN_CAP) { atomicAdd(&bar[XB_TMO], 1u); break; } }
    }
    nloc = mine > 0u ? mine : 1u; nx = cnt > 0u ? cnt : 1u;
}
__device__ __forceinline__ void xcd_barrier(const XcdBarrier& b) {
    asm volatile("s_waitcnt vmcnt(0)" ::: "memory");
    __syncthreads();
    if (threadIdx.x == 0) {
        unsigned* bar = b.bar;
        __builtin_amdgcn_s_waitcnt(0);
        unsigned nloc = b.st[0], nx = b.st[1];
        if (nloc == 0u) { xcd_barrier_complete(bar, b.x, nloc, nx); b.st[0] = nloc; b.st[1] = nx; }
        const unsigned old = xb_add(&bar[XB_XSUB(b.x)], 1u);
        const unsigned gen = old / nloc;
        if (old + 1u == (gen + 1u) * nloc) {
            __builtin_amdgcn_fence(__ATOMIC_RELEASE, "agent");
            asm volatile("s_waitcnt vmcnt(0)" ::: "memory");
            const unsigned og = xb_add(&bar[XB_TOP], 1u);
            const unsigned tg = og / nx;
            if (og + 1u == (tg + 1u) * nx) xb_add(&bar[XB_TOPGEN], 1u);
            else XB_SPIN(xb_ld(&bar[XB_TOPGEN]) == tg, bar);
            __builtin_amdgcn_fence(__ATOMIC_ACQUIRE, "agent");
            xb_add(&bar[XB_XGEN(b.x)], 1u);
            asm volatile("s_waitcnt vmcnt(0)" ::: "memory");
        } else {
            XB_SPIN(xb_ld(&bar[XB_XGEN(b.x)]) == gen, bar);
            __builtin_amdgcn_fence(__ATOMIC_ACQUIRE, "agent");
            asm volatile("s_waitcnt vmcnt(0)" ::: "memory");
        }
    }
    __syncthreads();
}

namespace pg8 {
#define PG8_LAS __attribute__((address_space(3)))
constexpr int BM = 256, BK = 64, HALF = 128, HTB = HALF * BK * 2, STAGE_BYTES = 8 * HTB, NXCD = 8, WGM = 8;
__host__ __device__ __forceinline__ int lds_byte(int r, int c) { const int st = (r >> 4) * 2 + (c >> 5), rr = r & 15, cc = c & 31, ob = rr * 64 + cc * 2; return st * 1024 + (ob ^ (((ob >> 9) & 1) << 5)); }
__host__ __device__ __forceinline__ void stage_rc(int b, int& R, int& C) { const int st = b / 1024, sb = b % 1024, swz = sb ^ (((sb >> 9) & 1) << 5); R = (st >> 1) * 16 + swz / 64; C = (st & 1) * 32 + (swz % 64) / 2; }
__host__ __device__ __forceinline__ int perm32(int rho) { const int n = rho >> 4, i = rho & 15; return 8 * (i >> 2) + 4 * n + (i & 3); }

typedef int v4i_t __attribute__((ext_vector_type(4)));
typedef int v8i_t __attribute__((ext_vector_type(8)));
typedef float f32x8 __attribute__((ext_vector_type(8)));
struct Unit { const char* a; const char* b; int pm, pn, kind; };

__device__ __forceinline__ bool tile_order(long L, int nM, int nN, int& pm, int& pn) {
    const int nwg = nM * nN; if (L >= nwg) return false;
    int wgid = (int)L; { const int q = nwg / NXCD, r = nwg % NXCD, xcd = wgid % NXCD, off = wgid / NXCD; wgid = (xcd < r ? xcd * (q + 1) : r * (q + 1) + (xcd - r) * q) + off; }
    const int nig = WGM * nN, gid = wgid / nig, fm = gid * WGM, gsz = (nM - fm) < WGM ? (nM - fm) : WGM;
    pm = fm + ((wgid % nig) % gsz); pn = (wgid % nig) / gsz; return true;
}

template <class Epi, class Sched, bool ALIGN_EPI, bool FP8 = false>
__device__ __forceinline__ void gemm_phase(PG8_LAS unsigned char* lds, const int KB, const Sched& S, const Epi& E) {
    int tid_ = threadIdx.x; asm volatile("" : "+v"(tid_));
    const int tid = tid_, wid = __builtin_amdgcn_readfirstlane(tid >> 6), lane = tid & 63, wr = wid >> 2, wc = wid & 3, fr = lane & 15, fq = lane >> 4;
    const int nt = KB / 128;
    unsigned voffA[2], voffB[2];
#pragma unroll
    for (int i = 0; i < 2; ++i) { int R, C; stage_rc(tid * 16 + i * 8192, R, C); const int Rb = (R & ~31) + perm32(R & 31);
        voffA[i] = (unsigned)(R * KB + C * 2); voffB[i] = (unsigned)(Rb * KB + C * 2); }
    const size_t kstep = (size_t)(BK * 2);
    const size_t hstep = (size_t)HALF * KB;
    const unsigned ldsw = (unsigned)wid * 1024u;
    const int aoff = lds_byte(wr * 64 + fr, fq * 8), boff = lds_byte(wc * 32 + fr, fq * 8);
#define PG8_SA(b, h) (((b) * 2 + (h)) * HTB)
#define PG8_SB(b, h) ((4 + (b) * 2 + (h)) * HTB)
#define PG8_STAGE(bufoff, gbase, voff) do { _Pragma("unroll") for (int _i = 0; _i < 2; ++_i) \
        __builtin_amdgcn_global_load_lds((const unsigned*)((const char*)(gbase) + (voff)[_i]), (PG8_LAS unsigned*)(lds + (bufoff) + ldsw + _i * 8192), 16, 0, 0); } while (0)
#define PG8_RD(off) (*(const PG8_LAS v4i_t*)(lds + (off)))
#define PG8_LDA(dst, b, h) do { _Pragma("unroll") for (int m = 0; m < 4; ++m) { \
        if constexpr (FP8) dst##8[m] = __builtin_shufflevector(PG8_RD(PG8_SA(b, h) + aoff + m * 2048), PG8_RD(PG8_SA(b, h) + aoff + m * 2048 + 1024), 0, 1, 2, 3, 4, 5, 6, 7); \
        else { _Pragma("unroll") for (int k = 0; k < 2; ++k) dst[m][k] = *(const PG8_LAS bf16x8*)(lds + PG8_SA(b, h) + aoff + m * 2048 + k * 1024); } } } while (0)
#define PG8_LDB(dst, b, h) do { _Pragma("unroll") for (int n = 0; n < 2; ++n) { \
        if constexpr (FP8) dst##8[n] = __builtin_shufflevector(PG8_RD(PG8_SB(b, h) + boff + n * 2048), PG8_RD(PG8_SB(b, h) + boff + n * 2048 + 1024), 0, 1, 2, 3, 4, 5, 6, 7); \
        else { _Pragma("unroll") for (int k = 0; k < 2; ++k) dst[n][k] = *(const PG8_LAS bf16x8*)(lds + PG8_SB(b, h) + boff + n * 2048 + k * 1024); } } } while (0)
#define PG8_MMA(ai, bj, At, Bt) do { __builtin_amdgcn_s_setprio(1); \
        if constexpr (FP8) { _Pragma("unroll") for (int m = 0; m < 4; ++m) _Pragma("unroll") for (int n = 0; n < 2; ++n) \
            asm volatile("v_mfma_f32_16x16x128_f8f6f4 %0, %1, %2, %0" : "+v"(acc[ai][bj][m][n]) : "v"(Bt##8[n]), "v"(At##8[m])); } \
        else { _Pragma("unroll") for (int m = 0; m < 4; ++m) _Pragma("unroll") for (int n = 0; n < 2; ++n) _Pragma("unroll") for (int k = 0; k < 2; ++k) \
            acc[ai][bj][m][n] = __builtin_amdgcn_mfma_f32_16x16x32_bf16(Bt[n][k], At[m][k], acc[ai][bj][m][n], 0, 0, 0); } \
        __builtin_amdgcn_s_setprio(0); } while (0)
#define PG8_WAIT_V(n) asm volatile("s_waitcnt vmcnt(" #n ")" ::: "memory")
#define PG8_WAIT_L(n) asm volatile("s_waitcnt lgkmcnt(" #n ")" ::: "memory")
#define PG8_BAR __builtin_amdgcn_s_barrier()
#define PG8_SCHED __builtin_amdgcn_sched_barrier(0)
    Unit cur, nxt; int ui = 0;
    if (!S.next(0, cur)) return;
    f32x4 acc[2][2][4][2];
#pragma unroll
    for (int a = 0; a < 2; ++a)
#pragma unroll
        for (int b = 0; b < 2; ++b)
#pragma unroll
            for (int m = 0; m < 4; ++m)
#pragma unroll
                for (int n = 0; n < 2; ++n) acc[a][b][m][n] = (f32x4){0.f, 0.f, 0.f, 0.f};
    bf16x8 At[4][2], B0[2][2], B1[2][2]; v8i_t At8[4], B08[2], B18[2];
    const char* cA = cur.a; const char* cB = cur.b;
    PG8_STAGE(PG8_SB(0, 0), cB, voffB); PG8_STAGE(PG8_SB(0, 1), cB + hstep, voffB); PG8_STAGE(PG8_SA(0, 0), cA, voffA); PG8_STAGE(PG8_SA(0, 1), cA + hstep, voffA);
    if (wr == 1) PG8_BAR;
    PG8_WAIT_V(2); PG8_BAR;
    PG8_STAGE(PG8_SB(1, 0), cB + kstep, voffB); PG8_STAGE(PG8_SA(1, 0), cA + kstep, voffA); PG8_STAGE(PG8_SB(1, 1), cB + hstep + kstep, voffB);
    PG8_WAIT_V(6); PG8_BAR;
    for (;;) {
        const bool has_next = S.next(ui + 1, nxt);
        const char* nA = has_next ? nxt.a : cA; const char* nB = has_next ? nxt.b : cB;
#pragma nounroll
        for (int t = 0; t < nt; t += 2) {
            const bool last = (t == nt - 2);
            const char* a1 = cA + (size_t)(t + 1) * kstep;
            const char* a2 = last ? nA : cA + (size_t)(t + 2) * kstep; const char* b2 = last ? nB : cB + (size_t)(t + 2) * kstep;
            const char* a3 = a2 + kstep; const char* b3 = b2 + kstep;
            PG8_LDB(B0, 0, 0); PG8_LDB(B1, 0, 1); PG8_SCHED; PG8_LDA(At, 0, 0); PG8_STAGE(PG8_SA(1, 1), a1 + hstep, voffA);
            PG8_WAIT_V(8); PG8_WAIT_L(0); PG8_BAR; PG8_MMA(0, 0, At, B0); PG8_MMA(0, 1, At, B1); PG8_BAR; PG8_SCHED;
            PG8_LDA(At, 0, 1); PG8_STAGE(PG8_SB(0, 0), b2, voffB); PG8_STAGE(PG8_SB(0, 1), b2 + hstep, voffB); PG8_STAGE(PG8_SA(0, 0), a2, voffA);
            PG8_WAIT_V(8); PG8_WAIT_L(0); PG8_BAR; PG8_MMA(1, 0, At, B0); PG8_MMA(1, 1, At, B1); PG8_BAR; PG8_SCHED;
            PG8_LDB(B0, 1, 0); PG8_LDB(B1, 1, 1); PG8_SCHED; PG8_LDA(At, 1, 0); PG8_STAGE(PG8_SA(0, 1), a2 + hstep, voffA);
            PG8_WAIT_V(8); PG8_WAIT_L(0); PG8_BAR; PG8_MMA(0, 0, At, B0); PG8_MMA(0, 1, At, B1); PG8_BAR; PG8_SCHED;
            PG8_LDA(At, 1, 1); PG8_STAGE(PG8_SB(1, 0), b3, voffB); PG8_STAGE(PG8_SB(1, 1), b3 + hstep, voffB); PG8_STAGE(PG8_SA(1, 0), a3, voffA);
            PG8_WAIT_V(8); PG8_WAIT_L(0); PG8_BAR; PG8_MMA(1, 0, At, B0); PG8_MMA(1, 1, At, B1); PG8_BAR; PG8_SCHED;
        }
        if constexpr (ALIGN_EPI) { if (wr == 0) PG8_BAR; }
        if constexpr (FP8) asm volatile("s_nop 15\n\ts_nop 7" ::: "memory");
        E(acc, cur, wr, wc, fr, fq);
        if (!has_next) break;
#pragma unroll
        for (int a = 0; a < 2; ++a)
#pragma unroll
            for (int b = 0; b < 2; ++b)
#pragma unroll
                for (int m = 0; m < 4; ++m)
#pragma unroll
                    for (int n = 0; n < 2; ++n) acc[a][b][m][n] = (f32x4){0.f, 0.f, 0.f, 0.f};
        cur = nxt; cA = nA; cB = nB; ++ui;
        if constexpr (ALIGN_EPI) { if (wr == 1) PG8_BAR; }
    }
    PG8_WAIT_V(0);
    if constexpr (!ALIGN_EPI) { if (wr == 0) PG8_BAR; }
    PG8_BAR;
#undef PG8_SA
#undef PG8_SB
#undef PG8_STAGE
#undef PG8_LDA
#undef PG8_LDB
#undef PG8_MMA
#undef PG8_RD
#undef PG8_WAIT_V
#undef PG8_WAIT_L
#undef PG8_BAR
#undef PG8_SCHED
}

typedef const f32x4 (&AccRef)[2][2][4][2];
typedef const f32x8 (&Acc8Ref)[2][2][4];
struct RowScale {
    const float* ssq; const float* direct;
    __device__ __forceinline__ float get(int row, int fq) const {
        if (direct) return direct[row];
        const f32x4 p = *(const f32x4*)(ssq + (size_t)row * 16 + fq * 4);
        float s = (p[0] + p[1]) + (p[2] + p[3]); s += __shfl_xor(s, 16); s += __shfl_xor(s, 32);
        return rsqrtf(s * (1.0f / D) + RMS_EPS);
    }
};
template <bool SIGB>
__device__ __forceinline__ void epi_glu(AccRef acc, const RowScale& R, const float* b0, const float* b1, bf16_t* out, int ld, int row0, int ch0, int fq) {
    f32x4 ba[2], bg[2];
#pragma unroll
    for (int n = 0; n < 2; ++n) { ba[n] = SIGB ? *(const f32x4*)(b0 + ch0 + 4 * n) : (f32x4){0.f, 0.f, 0.f, 0.f}; bg[n] = SIGB ? *(const f32x4*)(b1 + ch0 + 4 * n) : (f32x4){0.f, 0.f, 0.f, 0.f}; }
#pragma unroll
    for (int ai = 0; ai < 2; ++ai)
#pragma unroll
        for (int m = 0; m < 4; ++m) {
            const int row = row0 + ai * HALF + m * 16; const float r = R.get(row, fq); f32x4 o[2];
#pragma unroll
            for (int n = 0; n < 2; ++n) {
                f32x4 a = acc[ai][0][m][n] * r + ba[n], g = acc[ai][1][m][n] * r + bg[n];
#pragma unroll
                for (int j = 0; j < 4; ++j) o[n][j] = SIGB ? a[j] * sigmoidf_fast(g[j]) : a[j] * sigmoidf_fast(a[j]) * g[j];
            }
            u32x4 w; w.x = cvt_pk_bf16(o[0][0], o[0][1]); w.y = cvt_pk_bf16(o[0][2], o[0][3]); w.z = cvt_pk_bf16(o[1][0], o[1][1]); w.w = cvt_pk_bf16(o[1][2], o[1][3]);
            *(u32x4*)(out + (size_t)row * ld + ch0) = w;
            asm volatile("" ::: "memory");
        }
}
__device__ __forceinline__ void epi_head(AccRef acc, const RowScale& R, const float* gain, float scale, bf16_t* out, int ld, int row0, int col0, int fq) {
    f32x4 gv[2][2];
#pragma unroll
    for (int bj = 0; bj < 2; ++bj)
#pragma unroll
        for (int n = 0; n < 2; ++n) gv[bj][n] = gain ? *(const f32x4*)(gain + 32 * bj + 8 * fq + 4 * n) * scale : (f32x4){1.f, 1.f, 1.f, 1.f};
#pragma unroll
    for (int ai = 0; ai < 2; ++ai)
#pragma unroll
        for (int m = 0; m < 4; ++m) {
            const int row = row0 + ai * HALF + m * 16; const float r = R.get(row, fq); f32x4 v[2][2]; float ss = 0.f;
#pragma unroll
            for (int bj = 0; bj < 2; ++bj)
#pragma unroll
                for (int n = 0; n < 2; ++n) { v[bj][n] = acc[ai][bj][m][n] * r; const f32x4 q = v[bj][n] * v[bj][n]; ss += (q[0] + q[1]) + (q[2] + q[3]); }
            ss += __shfl_xor(ss, 16); ss += __shfl_xor(ss, 32);
            const float rinv = gain ? rsqrtf(ss * (1.0f / 64.0f) + RMS_EPS) : 1.0f;
#pragma unroll
            for (int bj = 0; bj < 2; ++bj) {
                const f32x4 x0 = v[bj][0] * rinv * gv[bj][0], x1 = v[bj][1] * rinv * gv[bj][1];
                u32x4 w; w.x = cvt_pk_bf16(x0[0], x0[1]); w.y = cvt_pk_bf16(x0[2], x0[3]); w.z = cvt_pk_bf16(x1[0], x1[1]); w.w = cvt_pk_bf16(x1[2], x1[3]);
                *(u32x4*)(out + (size_t)row * ld + col0 + 32 * bj + 8 * fq) = w;
            }
            asm volatile("" ::: "memory");
        }
}
__device__ __forceinline__ void epi_resid(AccRef acc, const float* res, float* outf, bf16_t* outb, float* ssq, int row0, int col0, int slot, int fq) {
#pragma unroll
    for (int ai = 0; ai < 2; ++ai)
#pragma unroll
        for (int m = 0; m < 4; ++m) {
            const size_t ro = (size_t)(row0 + ai * HALF + m * 16) * D + col0; float ss = 0.f;
#pragma unroll
            for (int bj = 0; bj < 2; ++bj) {
                const f32x4 o0 = *(const f32x4*)(res + ro + bj * HALF) + acc[ai][bj][m][0], o1 = *(const f32x4*)(res + ro + bj * HALF + 4) + acc[ai][bj][m][1];
                const f32x4 q0 = o0 * o0, q1 = o1 * o1; ss += ((q0[0] + q0[1]) + (q0[2] + q0[3])) + ((q1[0] + q1[1]) + (q1[2] + q1[3]));
                *(f32x4*)(outf + ro + bj * HALF) = o0; *(f32x4*)(outf + ro + bj * HALF + 4) = o1;
                u32x4 w; w.x = cvt_pk_bf16(o0[0], o0[1]); w.y = cvt_pk_bf16(o0[2], o0[3]); w.z = cvt_pk_bf16(o1[0], o1[1]); w.w = cvt_pk_bf16(o1[2], o1[3]);
                *(u32x4*)(outb + ro + bj * HALF) = w;
            }
            ss += __shfl_xor(ss, 16); ss += __shfl_xor(ss, 32);
            if (fq == 0) ssq[(size_t)(row0 + ai * HALF + m * 16) * 16 + slot] = ss;
            asm volatile("" ::: "memory");
        }
}
}

struct Args { const float* in[30]; float* out; unsigned char* ws; int ph_lo, ph_hi; };
struct Frame {
    LAS unsigned char* lds;
    volatile LAS unsigned* MISC;
    gu32* ctl;
    int tid, lane, wave, G;
    unsigned char* ws;
    float* out;
};
enum InIdx { I_X = 0, I_MEM, I_MEM_NORM_G, I_W_MEM_KV, I_MEM_K_NORM_G, I_CV_ATTN_NORM_G, I_CV_W_IN, I_CV_B_GLU, I_CV_DW_W, I_CV_DW_B, I_CV_LN_G, I_CV_LN_B,
             I_CV_MEMQ_NORM_G, I_CV_W_OUT, I_CV_FFN_NORM_G, I_CV_W_GATE, I_CV_W_UP, I_CV_W_DOWN, I_SW_ATTN_NORM_G, I_SW_W_IN, I_SW_Q_NORM_G, I_SW_K_NORM_G,
             I_SW_SINKS, I_SW_MEMQ_NORM_G, I_SW_W_OUT, I_SW_FFN_NORM_G, I_SW_ROUTER, I_SW_WE_GATE, I_SW_WE_UP, I_SW_WE_DOWN };

__device__ __forceinline__ void tr_item(const float* W, int N, int Kd, bf16* WT, int k0, int n0, int dst_row0, const float* gain, LAS float* scr, int lane) {
#pragma unroll 8
    for (int i = 0; i < 32; ++i) { const int kk = 2 * i + (lane >> 5); scr[kk * 33 + (lane & 31)] = W[(size_t)(k0 + kk) * N + n0 + (lane & 31)]; }
    LDS_WAIT(); asm volatile("" ::: "memory");
    const int c = lane & 7;
    f32x4 g0 = (f32x4){1.f, 1.f, 1.f, 1.f}, g1 = g0;
    if (gain) { g0 = *(const f32x4*)(gain + k0 + 8 * c); g1 = *(const f32x4*)(gain + k0 + 8 * c + 4); }
#pragma unroll
    for (int j = 0; j < 4; ++j) { const int n = (lane >> 3) + 8 * j; const LAS float* s = scr + (8 * c) * 33 + n;
        u32x4 o; o.x = pk2(s[0 * 33] * g0[0], s[1 * 33] * g0[1]); o.y = pk2(s[2 * 33] * g0[2], s[3 * 33] * g0[3]); o.z = pk2(s[4 * 33] * g1[0], s[5 * 33] * g1[1]); o.w = pk2(s[6 * 33] * g1[2], s[7 * 33] * g1[3]);
        *(u32x4*)(WT + (size_t)(dst_row0 + n) * Kd + k0 + 8 * c) = o; }
    LDS_WAIT(); asm volatile("" ::: "memory");
}
__device__ __forceinline__ void tr_item8(const float* W, int N, int Kd, unsigned char* WT, int k0, int n0, int dst_row0, const float* gain, float scale, LAS float* scr, int lane) {
#pragma unroll 8
    for (int i = 0; i < 32; ++i) { const int kk = 2 * i + (lane >> 5); scr[kk * 33 + (lane & 31)] = __builtin_nontemporal_load(W + (size_t)(k0 + kk) * N + n0 + (lane & 31)); }
    LDS_WAIT(); asm volatile("" ::: "memory");
    const int c = lane & 3;
    f32x4 g[4];
#pragma unroll
    for (int q = 0; q < 4; ++q) g[q] = gain ? *(const f32x4*)(gain + k0 + 16 * c + 4 * q) * scale : (f32x4){scale, scale, scale, scale};
#pragma unroll
    for (int j = 0; j < 2; ++j) { const int n = (lane >> 2) + 16 * j; const LAS float* sp = scr + (16 * c) * 33 + n; u32x4 o;
#pragma unroll
        for (int q = 0; q < 4; ++q) o[q] = pk4_fp8(sp[(4 * q + 0) * 33] * g[q][0], sp[(4 * q + 1) * 33] * g[q][1], sp[(4 * q + 2) * 33] * g[q][2], sp[(4 * q + 3) * 33] * g[q][3]);
        *(u32x4*)(WT + (size_t)(dst_row0 + n) * Kd + k0 + 16 * c) = o; }
    LDS_WAIT(); asm volatile("" ::: "memory");
}
__device__ __forceinline__ int map_glu(int ch, int part) { return 256 * (ch >> 7) + 128 * part + (ch & 127); }
__device__ __forceinline__ int map_head(int n) { return 256 * (n >> 8) + 128 * ((n >> 5) & 1) + 32 * ((n >> 6) & 3) + (n & 31); }

__device__ __forceinline__ void row_to_bf16_ssq(const float* xrow, bf16* orow, float* ssq, int lane) {
    const f32x4* xr = (const f32x4*)xrow + lane;
    f32x4 v[4]; float s = 0.f;
#pragma unroll
    for (int j = 0; j < 4; ++j) { v[j] = xr[64 * j]; s += (v[j][0] * v[j][0] + v[j][1] * v[j][1]) + (v[j][2] * v[j][2] + v[j][3] * v[j][3]); }
    s = wave_sum(s);
    u32x2* o8 = (u32x2*)orow + lane;
#pragma unroll
    for (int j = 0; j < 4; ++j) { u32x2 w; w.x = pk2(v[j][0], v[j][1]); w.y = pk2(v[j][2], v[j][3]); o8[64 * j] = w; }
    if (lane < 16) ssq[lane] = (lane == 0) ? s : 0.f;
}

__device__ __forceinline__ void p0_prologue(Frame& F, const Args& A) {
    LAS float* scr = (LAS float*)(F.lds + F.wave * 16384);
    const int gw = blockIdx.x * NWAVES + F.wave, NGW = F.G * NWAVES, lane = F.lane;
    unsigned char* ws = F.ws;
    constexpr int I0 = 16 * (N_IN0 / 32);
    constexpr int I1 = I0 + 16 * 32;
    constexpr int I2 = I1 + 16 * (FF / 32);
    constexpr int I3 = I2 + 16 * (FF / 32);
    constexpr int I4 = I3 + (FF / 64) * 32;
    constexpr int I5 = I4 + 16 * (N_IN1 / 32);
    constexpr int I6 = I5 + 16 * 32;
    constexpr int I7 = I6 + 16 * 16;
    for (int it = gw; it < I7; it += NGW) {
        if (it < I0) { const int r = it, nb = r % (N_IN0 / 32), kb = r / (N_IN0 / 32), n0 = nb * 32;
            const int dr = n0 < 768 ? map_glu(n0, 0) : (n0 < 1536 ? map_glu(n0 - 768, 1) : 1536 + map_head(n0 - 1536));
            tr_item(A.in[I_CV_W_IN], N_IN0, D, (bf16*)(ws + WS_WIN0), kb * 64, n0, dr, A.in[I_CV_ATTN_NORM_G], scr, lane); }
        else if (it < I1) { const int r = it - I0, nb = r % 32, kb = r / 32; tr_item(A.in[I_CV_W_OUT], D, D, (bf16*)(ws + WS_WOUT0), kb * 64, nb * 32, nb * 32, nullptr, scr, lane); }
        else if (it < I2) { const int r = it - I1, nb = r % (FF / 32), kb = r / (FF / 32); tr_item(A.in[I_CV_W_GATE], FF, D, (bf16*)(ws + WS_WGU0), kb * 64, nb * 32, map_glu(nb * 32, 0), A.in[I_CV_FFN_NORM_G], scr, lane); }
        else if (it < I3) { const int r = it - I2, nb = r % (FF / 32), kb = r / (FF / 32); tr_item(A.in[I_CV_W_UP], FF, D, (bf16*)(ws + WS_WGU0), kb * 64, nb * 32, map_glu(nb * 32, 1), A.in[I_CV_FFN_NORM_G], scr, lane); }
        else if (it < I4) { const int r = it - I3, nb = r % 32, kb = r / 32; tr_item(A.in[I_CV_W_DOWN], D, FF, (bf16*)(ws + WS_WDN0), kb * 64, nb * 32, nb * 32, nullptr, scr, lane); }
        else if (it < I5) { const int r = it - I4, nb = r % (N_IN1 / 32), kb = r / (N_IN1 / 32); tr_item(A.in[I_SW_W_IN], N_IN1, D, (bf16*)(ws + WS_WIN1), kb * 64, nb * 32, map_head(nb * 32), A.in[I_SW_ATTN_NORM_G], scr, lane); }
        else if (it < I6) { const int r = it - I5, nb = r % 32, kb = r / 32; tr_item(A.in[I_SW_W_OUT], D, D, (bf16*)(ws + WS_WOUT1), kb * 64, nb * 32, nb * 32, nullptr, scr, lane); }
        else { const int r = it - I6, nb = r % 16, kb = r / 16; tr_item(A.in[I_W_MEM_KV], 512, D, (bf16*)(ws + WS_WMKV), kb * 64, nb * 32, map_head(nb * 32), A.in[I_MEM_NORM_G], scr, lane); }
    }
    for (int m = gw; m < M; m += NGW) row_to_bf16_ssq(A.in[I_X] + (size_t)m * D, (bf16*)(ws + WS_HB) + (size_t)m * D, (float*)(ws + WS_SSQ) + (size_t)m * 16, lane);
    for (int m = gw; m < MEM_ROWS; m += NGW) row_to_bf16_ssq(A.in[I_MEM] + (size_t)m * D, (bf16*)(ws + WS_MEMB) + (size_t)m * D, (float*)(ws + WS_SSQM) + (size_t)m * 16, lane);
}

constexpr int MOE_PER_E = 16 * (FE / 32);
constexpr int MOE_ITEMS = 3 * NE * MOE_PER_E;
constexpr int CV_CHUNK = 4, CV_NCHUNK = MOE_ITEMS / CV_CHUNK;
static_assert(MOE_ITEMS % CV_CHUNK == 0, "chunks");
struct CvtItem { const float* W; unsigned char* WT; const float* gain; int N, Kd, k0, n0, dr; float scale; };
__device__ __forceinline__ CvtItem moe_cvt_decode(Frame& F, const Args& A, int r) {
    unsigned char* ws = F.ws; CvtItem it;
    if (r < 2 * NE * MOE_PER_E) { const bool up = r >= NE * MOE_PER_E; const int rr = up ? r - NE * MOE_PER_E : r, e = rr / MOE_PER_E, q = rr % MOE_PER_E, nb = q % (FE / 32), kb = q / (FE / 32);
        it.W = A.in[up ? I_SW_WE_UP : I_SW_WE_GATE] + (size_t)e * D * FE; it.N = FE; it.Kd = D; it.WT = ws + WS_WGUE + (size_t)e * 2 * FE * D; it.k0 = kb * 64; it.n0 = nb * 32; it.dr = map_glu(nb * 32, up ? 1 : 0); it.gain = A.in[I_SW_FFN_NORM_G]; it.scale = S_W; }
    else { const int rr = r - 2 * NE * MOE_PER_E, e = rr / MOE_PER_E, q = rr % MOE_PER_E, nb = q % 32, kb = q / 32;
        it.W = A.in[I_SW_WE_DOWN] + (size_t)e * FE * D; it.N = D; it.Kd = FE; it.WT = ws + WS_WDNE + (size_t)e * D * FE; it.k0 = kb * 64; it.n0 = nb * 32; it.dr = nb * 32; it.gain = nullptr; it.scale = S_WD; }
    return it;
}
__device__ __forceinline__ void cvt_load(const CvtItem& it, f32x4 (&v)[8], int lane) {
    const float* p = it.W + (size_t)(it.k0 + (lane >> 3)) * it.N + it.n0 + 4 * (lane & 7);
#pragma unroll
    for (int i = 0; i < 8; ++i) v[i] = __builtin_nontemporal_load((const f32x4*)(p + (size_t)(8 * i) * it.N));
}
__device__ __forceinline__ void cvt_emit(const CvtItem& it, const f32x4 (&v)[8], LAS float* scr, int lane) {
#pragma unroll
    for (int i = 0; i < 8; ++i) *(LAS f32x4*)(scr + ((lane >> 3) + 8 * i) * 36 + 4 * (lane & 7)) = v[i];
    LDS_WAIT(); asm volatile("" ::: "memory");
    const int n = lane & 31;
#pragma unroll
    for (int j = 0; j < 2; ++j) { const int ch = (lane >> 5) + 2 * j; const LAS float* sp = scr + (16 * ch) * 36 + n; u32x4 o;
#pragma unroll
        for (int q = 0; q < 4; ++q) { f32x4 g = (f32x4){it.scale, it.scale, it.scale, it.scale}; if (it.gain) g = *(const f32x4*)(it.gain + it.k0 + 16 * ch + 4 * q) * it.scale;
            o[q] = pk4_fp8(sp[(4 * q + 0) * 36] * g[0], sp[(4 * q + 1) * 36] * g[1], sp[(4 * q + 2) * 36] * g[2], sp[(4 * q + 3) * 36] * g[3]); }
        *(u32x4*)(it.WT + (size_t)(it.dr + n) * it.Kd + it.k0 + 16 * ch) = o; }
    LDS_WAIT(); asm volatile("" ::: "memory");
}
__device__ __forceinline__ void steal_convert(Frame& F, const Args& A, int k) {
    LAS float* scr = (LAS float*)(F.lds + F.wave * 16384);
    __syncthreads();
    if (k >= 0 && F.tid == 0) __hip_atomic_fetch_add(F.ctl + CW_DONE + 64 * k, 1u, RLX_AGENT);
    for (;;) {
        int idx = -1;
        if (F.lane == 0) { bool go = true;
            if (k >= 0) go = __hip_atomic_load(F.ctl + CW_DONE + 64 * k, RLX_AGENT) < (unsigned)F.G;
            if (go) { const unsigned cidx = __hip_atomic_fetch_add(F.ctl + CW_STEAL, 1u, RLX_AGENT); if (cidx < (unsigned)CV_NCHUNK) idx = (int)cidx; } }
        idx = __builtin_amdgcn_readfirstlane(idx);
        if (idx < 0) break;
        const int r0 = idx * CV_CHUNK;
        const CvtItem i0 = moe_cvt_decode(F, A, r0), i1 = moe_cvt_decode(F, A, r0 + 1), i2 = moe_cvt_decode(F, A, r0 + 2), i3 = moe_cvt_decode(F, A, r0 + 3);
        f32x4 v0[8], v1[8], v2[8], v3[8]; cvt_load(i0, v0, F.lane); cvt_load(i1, v1, F.lane); cvt_load(i2, v2, F.lane); cvt_load(i3, v3, F.lane);
        cvt_emit(i0, v0, scr, F.lane); cvt_emit(i1, v1, scr, F.lane); cvt_emit(i2, v2, scr, F.lane); cvt_emit(i3, v3, scr, F.lane);
    }
    __syncthreads();
}

using pg8::Unit; using pg8::f32x8;
struct DenseSched {
    const char* A; const char* Bt; int nM, nN, KB, G, c;
    __device__ __forceinline__ bool next(int i, Unit& u) const {
        const long L = (long)i * G + c; int pm, pn;
        if (!pg8::tile_order(L, nM, nN, pm, pn)) return false;
        u.pm = pm; u.pn = pn; u.kind = 0; u.a = A + (size_t)pm * 256 * KB; u.b = Bt + (size_t)pn * 256 * KB; return true;
    }
};
struct Dense2Sched {
    const char* A; const char* Bt; int nM, nN, KB, G, c; const char* A2; const char* B2;
    __device__ __forceinline__ bool next(int i, Unit& u) const {
        const long L = (long)i * G + c; const int nwg = nM * nN;
        if (L >= nwg + 4) return false;
        if (L < nwg) { int pm, pn; pg8::tile_order(L, nM, nN, pm, pn); u.pm = pm; u.pn = pn; u.kind = 0; u.a = A + (size_t)pm * 256 * KB; u.b = Bt + (size_t)pn * 256 * KB; }
        else { const int r = (int)(L - nwg); u.pm = r >> 1; u.pn = r & 1; u.kind = 1; u.a = A2 + (size_t)u.pm * 256 * KB; u.b = B2 + (size_t)u.pn * 256 * KB; }
        return true;
    }
};
struct MoeSched {
    const char* A; const char* W; int nN, KB, G, c; int ts1, ts2, ts3, ts4, ts5, ts6, ts7, ts8; size_t wstride; int x, r0;
    __device__ __forceinline__ void init_counts(const gu32* cnt, int pass) {
        int t = 0; int s[9]; s[0] = 0;
#pragma unroll
        for (int e = 0; e < 8; ++e) { const int c0 = (int)__hip_atomic_load(cnt + e * 64, RLX_AGENT), c1 = (int)__hip_atomic_load(cnt + (8 + e) * 64, RLX_AGENT);
            t += pass == 0 ? (c0 + (c1 & 255) + 255) >> 8 : c1 >> 8; s[e + 1] = t; }
        ts1 = s[1]; ts2 = s[2]; ts3 = s[3]; ts4 = s[4]; ts5 = s[5]; ts6 = s[6]; ts7 = s[7]; ts8 = s[8]; x = 0; r0 = 0;
    }
    __device__ __forceinline__ bool next(int i, Unit& u) const {
        const int nB = G - x;
        const long L = (c >= x) ? (i < r0 ? (long)i * nB + (c - x) : (long)r0 * nB + (long)(i - r0) * G + c) : (long)r0 * nB + (long)i * G + c;
        int pm, pn; if (!pg8::tile_order(L, ts8, nN, pm, pn)) return false;
        const int e = (pm >= ts1) + (pm >= ts2) + (pm >= ts3) + (pm >= ts4) + (pm >= ts5) + (pm >= ts6) + (pm >= ts7);
        u.pm = pm; u.pn = pn; u.kind = e; u.a = A + (size_t)pm * 256 * KB; u.b = W + (size_t)e * wstride + (size_t)pn * 256 * KB; return true;
    }
};

struct EpiInProj0 {
    const float* ssq; const float* ssqm; const float* b_glu; const float* memq_g; const float* memk_g; bf16* U; bf16* QM; bf16* MK; bf16* MV;
    __device__ __forceinline__ void operator()(pg8::AccRef acc, const Unit& u, int wr, int wc, int fr, int fq) const {
        const int row0 = u.pm * 256 + wr * 64 + fr;
        if (u.kind == 0) { const pg8::RowScale R{ssq, nullptr};
            if (u.pn < 6) pg8::epi_glu<true>(acc, R, b_glu, b_glu + CONV_CH, U, CONV_CH, row0, u.pn * 128 + wc * 32 + fq * 8, fq);
            else pg8::epi_head(acc, R, memq_g, QSCALE, QM, 256, row0, wc * 64, fq);
        } else { const pg8::RowScale R{ssqm, nullptr};
            if (u.pn == 0) pg8::epi_head(acc, R, memk_g, 1.0f, MK, 256, row0, wc * 64, fq);
            else pg8::epi_head(acc, R, nullptr, 1.0f, MV, 256, row0, wc * 64, fq);
        }
    }
};
struct EpiInProj1 {
    const float* ssq; const float* q_g; const float* k_g; const float* memq_g; bf16* Q; bf16* Kb; bf16* Vb; bf16* QM;
    __device__ __forceinline__ void operator()(pg8::AccRef acc, const Unit& u, int wr, int wc, int fr, int fq) const {
        const int row0 = u.pm * 256 + wr * 64 + fr; const pg8::RowScale R{ssq, nullptr};
        if (u.pn < 3) pg8::epi_head(acc, R, q_g, QSCALE, Q, 768, row0, u.pn * 256 + wc * 64, fq);
        else if (u.pn == 3) pg8::epi_head(acc, R, k_g, 1.0f, Kb, 256, row0, wc * 64, fq);
        else if (u.pn == 4) pg8::epi_head(acc, R, nullptr, 1.0f, Vb, 256, row0, wc * 64, fq);
        else pg8::epi_head(acc, R, memq_g, QSCALE, QM, 256, row0, wc * 64, fq);
    }
};
struct EpiResid {
    const float* res; float* outf; bf16* outb; float* ssq;
    __device__ __forceinline__ void operator()(pg8::AccRef acc, const Unit& u, int wr, int wc, int fr, int fq) const {
        pg8::epi_resid(acc, res, outf, outb, ssq, u.pm * 256 + wr * 64 + fr, u.pn * 256 + wc * 32 + fq * 8, u.pn * 4 + wc, fq);
    }
};
struct EpiSwiglu {
    const float* ssq; const float* rowr; bf16* act; int ld;
    __device__ __forceinline__ void operator()(pg8::AccRef acc, const Unit& u, int wr, int wc, int fr, int fq) const {
        const int row0 = u.pm * 256 + wr * 64 + fr; const pg8::RowScale R{ssq, rowr};
        pg8::epi_glu<false>(acc, R, nullptr, nullptr, act, ld, row0, u.pn * 128 + wc * 32 + fq * 8, fq);
    }
};
struct EpiSwiglu8 {
    unsigned char* act;
    __device__ __forceinline__ void operator()(pg8::AccRef acc, const Unit& u, int wr, int wc, int fr, int fq) const {
        const int row0 = u.pm * 256 + wr * 64 + fr, ch0 = u.pn * 128 + wc * 32 + fq * 8; constexpr float inv = 1.0f / (S_X * S_W);
#pragma unroll
        for (int ai = 0; ai < 2; ++ai)
#pragma unroll
            for (int m = 0; m < 4; ++m) { f32x4 o[2];
#pragma unroll
                for (int n = 0; n < 2; ++n) { const f32x4 g = acc[ai][0][m][n] * inv, v = acc[ai][1][m][n] * (inv * S_A);
#pragma unroll
                    for (int j = 0; j < 4; ++j) o[n][j] = g[j] * sigmoidf_fast(g[j]) * v[j]; }
                u32x2 w; w.x = pk4_fp8(o[0][0], o[0][1], o[0][2], o[0][3]); w.y = pk4_fp8(o[1][0], o[1][1], o[1][2], o[1][3]);
                *(u32x2*)(act + (size_t)(row0 + ai * 128 + m * 16) * FE + ch0) = w; }
    }
};
struct EpiMoeDown {
    const int* rowtok; const float* rowg; float* out; float gmul;
    __device__ __forceinline__ void operator()(pg8::AccRef acc, const Unit& u, int wr, int wc, int fr, int fq) const {
        const int row0 = u.pm * 256 + wr * 64 + fr, col0 = u.pn * 256 + wc * 32 + fq * 8;
#pragma unroll
        for (int ai = 0; ai < 2; ++ai)
#pragma unroll
            for (int m = 0; m < 4; ++m) {
                const int r = row0 + ai * 128 + m * 16; const int tk = rowtok[r];
                if (tk >= 0) { const float g = rowg[r] * (1.0f / (S_A * S_WD)) * gmul; float* op = out + (size_t)(tk & (TOK_ATOMIC - 1)) * D + col0;
                    if (tk & TOK_ATOMIC) {
#pragma unroll
                        for (int bj = 0; bj < 2; ++bj)
#pragma unroll
                            for (int n = 0; n < 2; ++n)
#pragma unroll
                                for (int j = 0; j < 4; ++j) unsafeAtomicAdd(op + bj * 128 + 4 * n + j, acc[ai][bj][m][n][j] * g);
                    } else {
#pragma unroll
                        for (int bj = 0; bj < 2; ++bj)
#pragma unroll
                            for (int n = 0; n < 2; ++n) { f32x4 t = *(const f32x4*)(op + bj * 128 + 4 * n); t += acc[ai][bj][m][n] * g; *(f32x4*)(op + bj * 128 + 4 * n) = t; } } }
            }
    }
};

struct ConvCtx { float w0[CONV_W], w1[CONV_W]; float b0, b1; };
constexpr int CV_C = 73728;
__device__ __forceinline__ void conv_unit(Frame& F, const ConvCtx& C, const bf16* U, bf16* MIX, const float* ln_g, const float* ln_b, int tile) {
    constexpr int TT = 16, ROWS = TT + CONV_W - 1;
    const int tok0 = tile * TT, b = tok0 / SEQ, s0 = tok0 % SEQ, tid = F.tid, lane = F.lane;
    LAS u32x4* l16 = (LAS u32x4*)F.lds;
    LAS unsigned* l4 = (LAS unsigned*)F.lds;
    LAS float* cres = (LAS float*)(F.lds + CV_C);
    __syncthreads();
    for (int idx = tid; idx < ROWS * 96; idx += NWAVES * 64) { const int r = idx / 96, c16 = idx % 96, s = s0 - (CONV_W - 1) + r;
        u32x4 v = (u32x4){0u, 0u, 0u, 0u}; if (s >= 0) v = *(const u32x4*)(U + ((size_t)b * SEQ + s) * CONV_CH + c16 * 8);
        l16[idx] = v; }
    __syncthreads();
    if (tid < 384) {
        float a0[TT], a1[TT];
#pragma unroll
        for (int t = 0; t < TT; ++t) { a0[t] = C.b0; a1[t] = C.b1; }
#pragma unroll
        for (int i = 0; i < ROWS; ++i) { const unsigned v = l4[i * 384 + tid]; const float x0 = bf_lo(v), x1 = bf_hi(v);
#pragma unroll
            for (int t = 0; t < TT; ++t) { const int j = i - t; if (j >= 0 && j < CONV_W) { a0[t] = fmaf(x0, C.w0[j], a0[t]); a1[t] = fmaf(x1, C.w1[j], a1[t]); } }
            if ((i & 3) == 3) __builtin_amdgcn_sched_barrier(0); }
#pragma unroll
        for (int t = 0; t < TT; ++t) *(LAS f32x2*)(cres + t * CONV_CH + 2 * tid) = (f32x2){a0[t], a1[t]};
    }
    __syncthreads();
#pragma unroll
    for (int tt = 0; tt < 2; ++tt) { const int t = 2 * F.wave + tt; f32x4 v[3]; float s1 = 0.f;
#pragma unroll
        for (int j = 0; j < 3; ++j) { v[j] = *(const LAS f32x4*)(cres + t * CONV_CH + 256 * j + 4 * lane); s1 += (v[j][0] + v[j][1]) + (v[j][2] + v[j][3]); }
        const float mean = wave_sum(s1) * (1.0f / CONV_CH); float s2 = 0.f;
#pragma unroll
        for (int j = 0; j < 3; ++j) { v[j] = v[j] - mean; const f32x4 q = v[j] * v[j]; s2 += (q[0] + q[1]) + (q[2] + q[3]); }
        const float rstd = rsqrtf(wave_sum(s2) * (1.0f / CONV_CH) + LN_EPS);
#pragma unroll
        for (int j = 0; j < 3; ++j) { const f32x4 g = *(const f32x4*)(ln_g + 256 * j + 4 * lane), bb = *(const f32x4*)(ln_b + 256 * j + 4 * lane);
            f32x4 y = v[j] * rstd * g + bb;
#pragma unroll
            for (int e = 0; e < 4; ++e) y[e] = y[e] * sigmoidf_fast(y[e]);
            u32x2 w; w.x = pk2(y[0], y[1]); w.y = pk2(y[2], y[3]);
            *(u32x2*)(MIX + (size_t)(tok0 + t) * D + 256 * j + 4 * lane) = w; }
    }
}

constexpr int AT_KS = 272 * 16, AT_VS = 272 * 32, AT_K = 0, AT_V = 8 * AT_KS;
__device__ __forceinline__ void attn_zero_pads(Frame& F) {
    __syncthreads();
    if (F.tid < 128) { const int c = F.tid >> 4, k = F.tid & 15; *(LAS u32x4*)(F.lds + AT_K + c * AT_KS + (256 + k) * 16) = (u32x4){0u, 0u, 0u, 0u}; }
    else if (F.tid < 256) { const int t = F.tid - 128, dq = t >> 5, h = t & 31; *(LAS u32x4*)(F.lds + AT_V + dq * AT_VS + 256 * 32 + h * 16) = (u32x4){0u, 0u, 0u, 0u}; }
    __syncthreads();
}
__device__ __forceinline__ void attn_load_kv(Frame& F, const bf16* Ks, const bf16* Vs, int pitch, int rowA, int rowB, int col0) {
    const int lane = F.lane, w = F.wave;
#pragma unroll
    for (int i = 0; i < 4; ++i) { const int p = w + 8 * i, c = p & 7, kq = p >> 3, key = 64 * kq + lane; const int row = key < 128 ? rowA + key : rowB + key - 128;
        __builtin_amdgcn_global_load_lds((const unsigned*)(Ks + (size_t)row * pitch + col0 + 8 * c), (LAS unsigned*)(F.lds + AT_K + c * AT_KS + kq * 1024), 16, 0, 0); }
#pragma unroll
    for (int i = 0; i < 4; ++i) { const int p = w + 8 * i, dq = p & 3, kg = p >> 2, key = 32 * kg + (lane >> 1); const int row = key < 128 ? rowA + key : rowB + key - 128;
        __builtin_amdgcn_global_load_lds((const unsigned*)(Vs + (size_t)row * pitch + col0 + 16 * dq + 8 * (lane & 1)), (LAS unsigned*)(F.lds + AT_V + dq * AT_VS + kg * 1024), 16, 0, 0); }
}
__device__ __forceinline__ s16x4 vtr(const LAS unsigned char* p) { typedef short v4i16_t __attribute__((ext_vector_type(4))); return __builtin_bit_cast(s16x4, __builtin_amdgcn_ds_read_tr16_b64_v4i16((LAS v4i16_t*)p)); }
template <int NKB, bool SWA>
__device__ __forceinline__ void attn_sub(const LAS unsigned char* lds, const bf16* Q, int qpitch, bf16* O, int kb0, int qpos0, bool first, float slope2, float sink2, int lane) {
    const int fr = lane & 15, fq = lane >> 4;
    bf16x8 qf[2];
#pragma unroll
    for (int ks = 0; ks < 2; ++ks) qf[ks] = *(const bf16x8*)(Q + (size_t)fr * qpitch + 32 * ks + 8 * fq);
    f32x4 s[NKB];
    const LAS unsigned char* kp = lds + AT_K + (16 * kb0 + fr) * 16 + fq * AT_KS;
#pragma unroll
    for (int jb = 0; jb < NKB; ++jb) {
        const bf16x8 k0 = *(const LAS bf16x8*)(kp + jb * 256), k1 = *(const LAS bf16x8*)(kp + jb * 256 + 4 * AT_KS);
        s[jb] = __builtin_amdgcn_mfma_f32_16x16x32_bf16(k0, qf[0], (f32x4){0.f, 0.f, 0.f, 0.f}, 0, 0, 0);
        s[jb] = __builtin_amdgcn_mfma_f32_16x16x32_bf16(k1, qf[1], s[jb], 0, 0, 0); }
    float mx = SWA ? sink2 : -3.0e38f;
#pragma unroll
    for (int jb = 0; jb < NKB; ++jb)
#pragma unroll
        for (int r = 0; r < 4; ++r) {
            if (SWA) { const int kpos = 16 * (kb0 + jb) + 4 * fq + r, dist = qpos0 + fr - kpos; const bool valid = (dist >= 0) && (dist < 128) && (!first || kpos >= 128);
                s[jb][r] = valid ? s[jb][r] - slope2 * (float)dist : -1.0e30f; }
            mx = fmaxf(mx, s[jb][r]); }
    mx = fmaxf(mx, __shfl_xor(mx, 16)); mx = fmaxf(mx, __shfl_xor(mx, 32));
    float l = 0.f;
#pragma unroll
    for (int jb = 0; jb < NKB; ++jb)
#pragma unroll
        for (int r = 0; r < 4; ++r) { const float p = __builtin_amdgcn_exp2f(s[jb][r] - mx); s[jb][r] = p; l += p; }
    l += __shfl_xor(l, 16); l += __shfl_xor(l, 32);
    if (SWA) l += __builtin_amdgcn_exp2f(sink2 - mx);
    const float rl = 1.0f / l;
    f32x4 o[4];
#pragma unroll
    for (int db = 0; db < 4; ++db) o[db] = (f32x4){0.f, 0.f, 0.f, 0.f};
    const LAS unsigned char* vp = lds + AT_V + (16 * kb0 + 4 * fq + (fr >> 2)) * 32 + (fr & 3) * 8;
#pragma unroll
    for (int kk = 0; kk < NKB / 2; ++kk) {
        u32x4 pw; pw.x = cvt_pk_bf16(s[2 * kk][0], s[2 * kk][1]); pw.y = cvt_pk_bf16(s[2 * kk][2], s[2 * kk][3]); pw.z = cvt_pk_bf16(s[2 * kk + 1][0], s[2 * kk + 1][1]); pw.w = cvt_pk_bf16(s[2 * kk + 1][2], s[2 * kk + 1][3]);
        const bf16x8 pf = __builtin_bit_cast(bf16x8, pw);
        const LAS unsigned char* va = vp + (2 * kk) * 512;
        const LAS unsigned char* vb = va + 512;
#pragma unroll
        for (int db = 0; db < 4; ++db) { const s16x4 lo = vtr(va + db * AT_VS), hi = vtr(vb + db * AT_VS);
            const bf16x8 vf = (bf16x8){lo[0], lo[1], lo[2], lo[3], hi[0], hi[1], hi[2], hi[3]};
            o[db] = __builtin_amdgcn_mfma_f32_16x16x32_bf16(vf, pf, o[db], 0, 0, 0); }
    }
#pragma unroll
    for (int db = 0; db < 4; ++db) { u32x2 w; w.x = cvt_pk_bf16(o[db][0] * rl, o[db][1] * rl); w.y = cvt_pk_bf16(o[db][2] * rl, o[db][3] * rl);
        *(u32x2*)(O + (size_t)fr * D + 16 * db + 4 * fq) = w; }
}
__device__ __forceinline__ void memattn_unit(Frame& F, const bf16* QM, const bf16* MK, const bf16* MV, bf16* MIX, int u) {
    const int b = u >> 7, rem = u & 127, qblk = rem >> 2, mh = rem & 3;
    __syncthreads();
    attn_load_kv(F, MK, MV, 256, b * MEM_LEN, b * MEM_LEN + 128, mh * HD);
    VM_WAIT(); __syncthreads();
#pragma unroll 1
    for (int i = 0; i < 2; ++i) { const int q0 = b * SEQ + qblk * 256 + 16 * (F.wave + 8 * i);
        attn_sub<16, false>(F.lds, QM + (size_t)q0 * 256 + mh * HD, 256, MIX + (size_t)q0 * D + 768 + mh * HD, 0, 0, false, 0.f, 0.f, F.lane); }
}
__device__ __forceinline__ void swa_unit(Frame& F, const bf16* Q, const bf16* Kb, const bf16* Vb, bf16* MIX, const float* sinks, int u) {
    const int b = u >> 8, rem = u & 255, n = rem >> 2, kvh = rem & 3;
    const int rowB = b * SEQ + n * 128, rowA = n > 0 ? rowB - 128 : rowB;
    __syncthreads();
    attn_load_kv(F, Kb, Vb, 256, rowA, rowB, kvh * HD);
    VM_WAIT(); __syncthreads();
#pragma unroll 1
    for (int g = 0; g < 3; ++g) { const int h = kvh * 3 + g, a = F.wave, q0 = rowB + 16 * a;
        const float slope2 = __builtin_amdgcn_exp2f(-8.0f * (float)(h + 1) / 12.0f) * LOG2E, sink2 = sinks[h] * LOG2E;
        attn_sub<10, true>(F.lds, Q + (size_t)q0 * 768 + h * HD, 768, MIX + (size_t)q0 * D + h * HD, a, 128 + 16 * a, n == 0, slope2, sink2, F.lane); }
}

__device__ __forceinline__ void router_phase(Frame& F, const Args& A, const bool dummy) {
    unsigned char* ws = F.ws + (dummy ? MiB : 0); const int lane = F.lane, w = F.wave; const int cw = CW_CNT + (dummy ? 2048 : 0);
    const float* g = A.in[I_SW_FFN_NORM_G]; const float* R = A.in[I_SW_ROUTER];
    int* tok_e = (int*)(ws + RT_TOKE); int* tok_s = (int*)(ws + RT_TOKS); float* tok_w = (float*)(ws + RT_TOKW); float* tok_r = (float*)(ws + RT_TOKR);
    LAS int* le = (LAS int*)F.lds; LAS float* lw = (LAS float*)(F.lds + 512);
    float gr[4][4][8];
#pragma unroll
    for (int j = 0; j < 4; ++j)
#pragma unroll
        for (int jj = 0; jj < 4; ++jj) { const int k = 4 * lane + 256 * j + jj; const float gk = g[k]; const f32x4 r0 = *(const f32x4*)(R + k * 8), r1 = *(const f32x4*)(R + k * 8 + 4);
#pragma unroll
            for (int e = 0; e < 4; ++e) { gr[j][jj][e] = gk * r0[e]; gr[j][jj][4 + e] = gk * r1[e]; } }
    for (int tb = blockIdx.x; tb < M / 64; tb += F.G) {
        __syncthreads();
#pragma unroll 1
        for (int i = 0; i < 8; ++i) { const int tl = w * 8 + i, t = tb * 64 + tl;
            const f32x4* xr = (const f32x4*)(F.out + (size_t)t * D) + lane;
            float ss = 0.f, lg[8];
#pragma unroll
            for (int e = 0; e < 8; ++e) lg[e] = 0.f;
#pragma unroll
            for (int j = 0; j < 4; ++j) { const f32x4 x = xr[64 * j];
#pragma unroll
                for (int jj = 0; jj < 4; ++jj) { ss = fmaf(x[jj], x[jj], ss);
#pragma unroll
                    for (int e = 0; e < 8; ++e) lg[e] = fmaf(x[jj], gr[j][jj][e], lg[e]); } }
            ss = wave_sum(ss);
#pragma unroll
            for (int e = 0; e < 8; ++e) lg[e] = wave_sum(lg[e]);
            const float rstd = rsqrtf(ss * (1.0f / D) + RMS_EPS);
            int e1 = 0; float v1 = lg[0];
#pragma unroll
            for (int e = 1; e < 8; ++e) if (lg[e] > v1) { v1 = lg[e]; e1 = e; }
            int e2 = -1; float v2 = -3.0e38f;
#pragma unroll
            for (int e = 0; e < 8; ++e) if (e != e1 && lg[e] > v2) { v2 = lg[e]; e2 = e; }
            const float w1 = 1.0f / (1.0f + __expf((v2 - v1) * rstd)), w2 = 1.0f - w1;
            if (lane == 0) { le[tl] = e1; le[64 + tl] = e2; lw[tl] = w1; lw[64 + tl] = w2; tok_r[t] = rstd; }
        }
        __syncthreads();
        if (w == 0) { const int t = tb * 64 + lane;
#pragma unroll
            for (int p = 0; p < 2; ++p) { const int e = le[p * 64 + lane]; int slot = 0;
#pragma unroll
                for (int ee = 0; ee < 8; ++ee) { const unsigned long long mask = __ballot(e == ee); const int c = __popcll(mask);
                    if (c) { unsigned base = 0; if (lane == 0) base = __hip_atomic_fetch_add(F.ctl + cw + (p * 8 + ee) * 64, (unsigned)c, RLX_AGENT);
                        base = __builtin_amdgcn_readfirstlane(base);
                        if (e == ee) slot = (int)base + __popcll(mask & ((1ull << lane) - 1ull)); } }
                tok_e[p * M + t] = e; tok_s[p * M + t] = slot; tok_w[p * M + t] = lw[p * 64 + lane]; } }
    }
}
__device__ __forceinline__ void gather_phase(Frame& F) {
    unsigned char* ws = F.ws; const int lane = F.lane;
    LAS int* L = (LAS int*)F.lds;
    __syncthreads();
    if (F.tid == 0) { int o0 = 0, o1 = 0;
        for (int e = 0; e < 8; ++e) { const int c0 = (int)__hip_atomic_load(F.ctl + CW_CNT + e * 64, RLX_AGENT), c1 = (int)__hip_atomic_load(F.ctl + CW_CNT + (8 + e) * 64, RLX_AGENT);
            const int f1 = c1 & ~255, n0 = c0 + (c1 & 255); L[e] = o0; L[8 + e] = c0; L[16 + e] = o1; L[24 + e] = f1; o0 += (n0 + 255) & ~255; L[32 + e] = o0; o1 += f1; } }
    __syncthreads();
    const int* tok_e = (const int*)(ws + RT_TOKE); const int* tok_s = (const int*)(ws + RT_TOKS); const float* tok_w = (const float*)(ws + RT_TOKW); const float* tok_r = (const float*)(ws + RT_TOKR);
    int* rowtok = (int*)(ws + RT_ROWTOK); float* rowg = (float*)(ws + RT_ROWG);
    unsigned char* XS = ws + WS_XS;
    const int gw = blockIdx.x * NWAVES + F.wave, NGW = F.G * NWAVES;
    for (int idx = gw; idx < 2 * M; idx += NGW) { const int p = idx / M, t = idx % M; const int e1 = tok_e[M + t], s1 = tok_s[M + t]; const bool left = s1 >= L[24 + e1];
        int r;
        if (p == 0) { const int e0 = tok_e[t]; r = L[e0] + tok_s[t]; }
        else r = left ? L[e1] + L[8 + e1] + (s1 - L[24 + e1]) : P0_ROWS + L[16 + e1] + s1;
        const float sc = tok_r[t] * S_X;
        const f32x4* src = (const f32x4*)(F.out + (size_t)t * D) + lane; unsigned* dst = (unsigned*)(XS + (size_t)r * D) + lane;
#pragma unroll
        for (int j = 0; j < 4; ++j) { const f32x4 v = src[64 * j] * sc; dst[64 * j] = pk4_fp8(v[0], v[1], v[2], v[3]); }
        if (lane == 0) { rowtok[r] = t | (left ? TOK_ATOMIC : 0); rowg[r] = tok_w[idx]; } }
    for (int idx = gw; idx < 8 * 256; idx += NGW) { const int e = idx >> 8, j = idx & 255; const int r = L[e] + L[8 + e] + ((int)__hip_atomic_load(F.ctl + CW_CNT + (8 + e) * 64, RLX_AGENT) & 255) + j;
        if (r < L[32 + e]) { unsigned* dst = (unsigned*)(XS + (size_t)r * D) + lane;
#pragma unroll
            for (int q = 0; q < 4; ++q) dst[64 * q] = 0u;
            if (lane == 0) { rowtok[r] = -1; rowg[r] = 0.f; } } }
}

constexpr int N_PHASES = 14;
__global__ void __launch_bounds__(NWAVES * 64, 2) fwd_kernel(const Args A) {
    extern __shared__ __attribute__((aligned(16))) unsigned char lds_raw[];
    Frame F;
    F.lds = (LAS unsigned char*)lds_raw;
    F.MISC = (volatile LAS unsigned*)(F.lds + MISC_OFF);
    F.tid = threadIdx.x; F.lane = F.tid & 63; F.wave = __builtin_amdgcn_readfirstlane(F.tid >> 6);
    F.G = gridDim.x; F.ws = A.ws; F.out = A.out;
    unsigned char* ws = A.ws;
    F.ctl = (gu32*)(ws + WS_CTL);
    for (int u = F.tid; u < (LDS_BYTES - LDSCTL_OFF) / 4; u += NWAVES * 64) ((LAS unsigned*)(F.lds + LDSCTL_OFF))[u] = 0u;
    __syncthreads();
    XcdBarrier bar; bar.bar = (unsigned*)(F.ctl + CW_BAR); bar.x = 0; bar.st = nullptr;
    if (!MK_PER_PHASE) bar = xcd_barrier_post((unsigned*)(F.ctl + CW_BAR), F.MISC + 8);
    const int lo = A.ph_lo, hi = A.ph_hi;
#define IN(k) (lo <= (k) && (k) < hi)
#define PH(k, ...) if (IN(k)) { constexpr bool second_ = false; (void)second_; __VA_ARGS__ } if ((((PROBE_REPEAT_MASK) >> (k)) & 1) && IN(k)) { constexpr bool second_ = true; (void)second_; xcd_barrier(bar); __VA_ARGS__ }
#define SEAM(k) do { if (IN(k) && IN((k) + 1)) { if (MK_PER_PHASE) { if (F.tid == 0) __hip_atomic_store(F.ctl + CW_TMO, 0xBADBA0u | (unsigned)(k), RLX_AGENT); } else xcd_barrier(bar); } } while (0)
    const int c = (int)blockIdx.x;
    bf16* HB = (bf16*)(ws + WS_HB); float* H = (float*)(ws + WS_H); float* SSQ = (float*)(ws + WS_SSQ); bf16* MIX = (bf16*)(ws + WS_MIX);

    PH(0, p0_prologue(F, A);) SEAM(0);
    PH(1,
        Dense2Sched S{(const char*)HB, (const char*)(ws + WS_WIN0), M / 256, N_IN0 / 256, 2 * D, F.G, c, (const char*)(ws + WS_MEMB), (const char*)(ws + WS_WMKV)};
        EpiInProj0 E{SSQ, (const float*)(ws + WS_SSQM), A.in[I_CV_B_GLU], A.in[I_CV_MEMQ_NORM_G], A.in[I_MEM_K_NORM_G], (bf16*)(ws + PJ_U), (bf16*)(ws + PJ_QM0), (bf16*)(ws + WS_MEMK), (bf16*)(ws + WS_MEMV)};
        pg8::gemm_phase<EpiInProj0, Dense2Sched, true>(F.lds, 2 * D, S, E);
        steal_convert(F, A, 1);
    ) SEAM(1);
    PH(2,
        ConvCtx C;
        { const int ch = 2 * (F.tid < 384 ? F.tid : 0); const float* dw = A.in[I_CV_DW_W];
          _Pragma("unroll")
          for (int j = 0; j < CONV_W; ++j) { const f32x2 wv = *(const f32x2*)(dw + j * CONV_CH + ch); C.w0[j] = wv[0]; C.w1[j] = wv[1]; }
          C.b0 = A.in[I_CV_DW_B][ch]; C.b1 = A.in[I_CV_DW_B][ch + 1]; }
        for (int u = c; u < M / 16; u += F.G) conv_unit(F, C, (const bf16*)(ws + PJ_U), MIX, A.in[I_CV_LN_G], A.in[I_CV_LN_B], u);
        attn_zero_pads(F);
        for (int u = c; u < 256; u += F.G) memattn_unit(F, (const bf16*)(ws + PJ_QM0), (const bf16*)(ws + WS_MEMK), (const bf16*)(ws + WS_MEMV), MIX, u);
        __syncthreads();
    ) SEAM(2);
    PH(3,
        DenseSched S{(const char*)MIX, (const char*)(ws + WS_WOUT0), M / 256, D / 256, 2 * D, F.G, c};
        EpiResid E{A.in[I_X], H, HB, SSQ};
        pg8::gemm_phase<EpiResid, DenseSched, true>(F.lds, 2 * D, S, E);
    ) SEAM(3);
    PH(4,
        DenseSched S{(const char*)HB, (const char*)(ws + WS_WGU0), M / 256, 2 * FF / 256, 2 * D, F.G, c};
        EpiSwiglu E{SSQ, nullptr, (bf16*)(ws + WS_ACT0), FF};
        pg8::gemm_phase<EpiSwiglu, DenseSched, true>(F.lds, 2 * D, S, E);
        steal_convert(F, A, 4);
    ) SEAM(4);
    PH(5,
        DenseSched S{(const char*)(ws + WS_ACT0), (const char*)(ws + WS_WDN0), M / 256, D / 256, 2 * FF, F.G, c};
        EpiResid E{H, second_ ? (float*)(ws + 384 * MiB) : H, second_ ? (bf16*)(ws + WS_XS) : HB, second_ ? (float*)(ws + WS_ROUTE) : SSQ};
        pg8::gemm_phase<EpiResid, DenseSched, true>(F.lds, 2 * FF, S, E);
    ) SEAM(5);
    PH(6,
        DenseSched S{(const char*)HB, (const char*)(ws + WS_WIN1), M / 256, N_IN1 / 256, 2 * D, F.G, c};
        EpiInProj1 E{SSQ, A.in[I_SW_Q_NORM_G], A.in[I_SW_K_NORM_G], A.in[I_SW_MEMQ_NORM_G], (bf16*)(ws + PJ_Q), (bf16*)(ws + PJ_K), (bf16*)(ws + PJ_V), (bf16*)(ws + PJ_QM1)};
        pg8::gemm_phase<EpiInProj1, DenseSched, true>(F.lds, 2 * D, S, E);
        steal_convert(F, A, 6);
    ) SEAM(6);
    PH(7,
        attn_zero_pads(F);
        for (int u = c; u < 512; u += F.G) swa_unit(F, (const bf16*)(ws + PJ_Q), (const bf16*)(ws + PJ_K), (const bf16*)(ws + PJ_V), MIX, A.in[I_SW_SINKS], u);
        for (int u = c; u < 256; u += F.G) memattn_unit(F, (const bf16*)(ws + PJ_QM1), (const bf16*)(ws + WS_MEMK), (const bf16*)(ws + WS_MEMV), MIX, u);
        __syncthreads();
    ) SEAM(7);
    PH(8,
        DenseSched S{(const char*)MIX, (const char*)(ws + WS_WOUT1), M / 256, D / 256, 2 * D, F.G, c};
        EpiResid E{H, F.out, HB, SSQ};
        pg8::gemm_phase<EpiResid, DenseSched, true>(F.lds, 2 * D, S, E);
    ) SEAM(8);
    PH(9, if (!second_) steal_convert(F, A, -1); router_phase(F, A, second_);) SEAM(9);
    PH(10, gather_phase(F);) SEAM(10);
    const gu32* cntp = F.ctl + CW_CNT;
    PH(11, { MoeSched S; S.A = (const char*)(ws + WS_XS); S.W = (const char*)(ws + WS_WGUE); S.nN = 2 * FE / 256; S.KB = D; S.G = F.G; S.c = c; S.wstride = (size_t)2 * FE * D; S.init_counts(cntp, 0);
             EpiSwiglu8 E{ws + WS_ACTE}; pg8::gemm_phase<EpiSwiglu8, MoeSched, true, true>(F.lds, D, S, E); }) SEAM(11);
    PH(12, { { MoeSched S; S.A = (const char*)(ws + WS_ACTE); S.W = (const char*)(ws + WS_WDNE); S.nN = D / 256; S.KB = FE; S.G = F.G; S.c = c; S.wstride = (size_t)D * FE; S.init_counts(cntp, 0);
               EpiMoeDown E{(const int*)(ws + RT_ROWTOK), (const float*)(ws + RT_ROWG), F.out, second_ ? 0.0f : 1.0f}; pg8::gemm_phase<EpiMoeDown, MoeSched, true, true>(F.lds, FE, S, E); }
             __builtin_amdgcn_sched_barrier(0);
             { MoeSched S; S.init_counts(cntp, 0); const int nD = S.ts8 * 4;
               S.A = (const char*)(ws + WS_XS) + (size_t)P0_ROWS * D; S.W = (const char*)(ws + WS_WGUE); S.nN = 2 * FE / 256; S.KB = D; S.G = F.G; S.c = c; S.wstride = (size_t)2 * FE * D; S.init_counts(cntp, 1);
               S.x = nD % F.G; S.r0 = S.x ? 4 : 0;
               EpiSwiglu8 E{ws + WS_ACTE + (size_t)P0_ROWS * FE}; pg8::gemm_phase<EpiSwiglu8, MoeSched, true, true>(F.lds, D, S, E); } }) SEAM(12);
    PH(13, { MoeSched S; S.A = (const char*)(ws + WS_ACTE) + (size_t)P0_ROWS * FE; S.W = (const char*)(ws + WS_WDNE); S.nN = D / 256; S.KB = FE; S.G = F.G; S.c = c; S.wstride = (size_t)D * FE; S.init_counts(cntp, 1);
             EpiMoeDown E{(const int*)(ws + RT_ROWTOK) + P0_ROWS, (const float*)(ws + RT_ROWG) + P0_ROWS, F.out, second_ ? 0.0f : 1.0f}; pg8::gemm_phase<EpiMoeDown, MoeSched, true, true>(F.lds, FE, S, E); })
#undef IN
#undef SEAM
}

extern "C" void kernel_launch(void* const* d_in, const int* in_sizes, int n_in, void* d_out, int out_size, void* d_ws, size_t ws_size, hipStream_t stream) {
    static int grid = 0;
    if (grid == 0) {
        if (n_in != 30 || in_sizes[0] != M * D || out_size != M * D || ws_size < WS_END) { fprintf(stderr, "kernel_launch: unexpected shapes: n_in %d in0 %d out %d ws %zu (need %zu)\n", n_in, n_in > 0 ? in_sizes[0] : -1, out_size, ws_size, (size_t)WS_END); grid = -1; return; }
        int dev = 0, cus = 0, per_cu = 0;
        if (hipGetDevice(&dev) != hipSuccess || hipDeviceGetAttribute(&cus, hipDeviceAttributeMultiprocessorCount, dev) != hipSuccess) { grid = -1; return; }
        if (hipFuncSetAttribute((const void*)fwd_kernel, hipFuncAttributeMaxDynamicSharedMemorySize, LDS_BYTES) != hipSuccess) { fprintf(stderr, "kernel_launch: hipFuncSetAttribute failed\n"); grid = -1; return; }
        if (hipOccupancyMaxActiveBlocksPerMultiprocessor(&per_cu, (const void*)fwd_kernel, NWAVES * 64, LDS_BYTES) != hipSuccess || per_cu < 1) fprintf(stderr, "kernel_launch: occupancy query reports %d\n", per_cu);
        (void)hipGetLastError();
        grid = cus;
    }
    if (grid < 0) return;
    if (hipMemsetAsync((char*)d_ws + WS_CTL, 0, CTL_ZERO_BYTES, stream) != hipSuccess) return;
    Args a{};
    for (int i = 0; i < 30; ++i) a.in[i] = (const float*)d_in[i];
    a.out = (float*)d_out; a.ws = (unsigned char*)d_ws;
#if MK_PER_PHASE
    for (int p = 0; p < N_PHASES; ++p) { a.ph_lo = p; a.ph_hi = p + 1; hipLaunchKernelGGL(fwd_kernel, dim3(grid), dim3(NWAVES * 64), LDS_BYTES, stream, a); }
#else
    a.ph_lo = 0; a.ph_hi = N_PHASES;
    hipLaunchKernelGGL(fwd_kernel, dim3(grid), dim3(NWAVES * 64), LDS_BYTES, stream, a);
#endif
}
```

```cpp
#include <hip/hip_runtime.h>
#include <cstdio>
#include <cstdint>

#ifndef MK_PER_PHASE
#define MK_PER_PHASE 0
#endif
#ifndef PROBE_REPEAT_MASK
#define PROBE_REPEAT_MASK 0
#endif

#define GAS __attribute__((address_space(1)))
#define LAS __attribute__((address_space(3)))
typedef unsigned short bf16;
typedef unsigned short bf16_t;
typedef short bf16x8 __attribute__((ext_vector_type(8)));
typedef short s16x4 __attribute__((ext_vector_type(4)));
typedef float f32x4 __attribute__((ext_vector_type(4)));
typedef float f32x2 __attribute__((ext_vector_type(2)));
typedef unsigned u32x4 __attribute__((ext_vector_type(4)));
typedef unsigned u32x2 __attribute__((ext_vector_type(2)));
typedef GAS unsigned gu32;

constexpr int BATCH = 2, SEQ = 8192, M = BATCH * SEQ, D = 1024;
constexpr int CONV_CH = 768, CONV_W = 31, MEMW = 256, HD = 64;
constexpr int N_IN0 = 2 * CONV_CH + MEMW;
constexpr int N_IN1 = 768 + 256 + 256 + 256;
constexpr int FF = 2816, NE = 8, FE = 3584;
constexpr int MEM_LEN = 256, MEM_ROWS = BATCH * MEM_LEN;
constexpr int P0_ROWS = 80 * 256;
constexpr int P1_ROWS = 64 * 256;
constexpr int TOK_ATOMIC = 0x40000000;
constexpr float RMS_EPS = 1e-6f, LN_EPS = 1e-5f;
constexpr float LOG2E = 1.4426950408889634f;
constexpr float QSCALE = 0.125f * LOG2E;
constexpr float S_X = 16.0f, S_W = 1024.0f, S_A = 8.0f, S_WD = 2048.0f;

constexpr size_t MiB = 1u << 20;
constexpr size_t WS_CTL = 0, CTL_ZERO_BYTES = 1 * MiB;
constexpr size_t WS_WIN0 = 1 * MiB;
constexpr size_t WS_WOUT0 = WS_WIN0 + (size_t)N_IN0 * D * 2;
constexpr size_t WS_WGU0 = WS_WOUT0 + (size_t)D * D * 2;
constexpr size_t WS_WDN0 = WS_WGU0 + (size_t)2 * FF * D * 2;
constexpr size_t WS_WIN1 = WS_WDN0 + (size_t)D * FF * 2;
constexpr size_t WS_WOUT1 = WS_WIN1 + (size_t)N_IN1 * D * 2;
constexpr size_t WS_WMKV = WS_WOUT1 + (size_t)D * D * 2;
constexpr size_t WS_MEMB = WS_WMKV + (size_t)512 * D * 2;
constexpr size_t WS_MEMK = WS_MEMB + (size_t)MEM_ROWS * D * 2;
constexpr size_t WS_MEMV = WS_MEMK + (size_t)MEM_ROWS * 256 * 2;
constexpr size_t WS_SSQM = WS_MEMV + (size_t)MEM_ROWS * 256 * 2;
constexpr size_t WS_SSQ = 31 * MiB;
constexpr size_t WS_WGUE = 32 * MiB;
constexpr size_t WS_WDNE = 88 * MiB;
constexpr size_t WS_HB = 200 * MiB;
constexpr size_t WS_H = 232 * MiB;
constexpr size_t WS_PROJ = 296 * MiB;
constexpr size_t WS_MIX = 344 * MiB;
constexpr size_t WS_ACT0 = 296 * MiB;
constexpr size_t WS_ACTE = 232 * MiB;
constexpr size_t WS_XS = 358 * MiB;
constexpr size_t WS_XN8 = 394 * MiB;
constexpr size_t WS_ROUTE = 430 * MiB;
constexpr size_t WS_END = 432 * MiB;
static_assert(WS_SSQM + MEM_ROWS * 16 * 4 <= WS_SSQ && WS_ACT0 + (size_t)M * FF * 2 <= WS_XS + 72 * MiB, "ws map");
static_assert(WS_ACTE + (size_t)(P0_ROWS + P1_ROWS) * FE <= WS_XS && WS_XS + (size_t)(P0_ROWS + P1_ROWS) * D <= WS_ROUTE, "ws map moe");
constexpr size_t PJ_U = WS_PROJ, PJ_QM0 = WS_PROJ + (size_t)M * 768 * 2;
constexpr size_t PJ_Q = WS_PROJ, PJ_K = PJ_Q + (size_t)M * 768 * 2, PJ_V = PJ_K + (size_t)M * 256 * 2, PJ_QM1 = PJ_V + (size_t)M * 256 * 2;
constexpr size_t RT_TOKE = WS_ROUTE;
constexpr size_t RT_TOKS = RT_TOKE + 2 * M * 4;
constexpr size_t RT_TOKW = RT_TOKS + 2 * M * 4;
constexpr size_t RT_TOKR = RT_TOKW + 2 * M * 4;
constexpr size_t RT_ROWTOK = RT_TOKR + M * 4;
constexpr size_t RT_ROWG = RT_ROWTOK + (P0_ROWS + P1_ROWS) * 4;
static_assert(RT_ROWG + (P0_ROWS + P1_ROWS) * 4 <= WS_ROUTE + MiB, "route map");
constexpr int CW_TMO = 0, CW_CODE = 1, CW_BAR = 4096, CW_CNT = 8192;
constexpr int CW_STEAL = 16384, CW_DONE = 16448;

constexpr int RING_BYTES = 131072;
constexpr int LDSCTL_OFF = RING_BYTES, MISC_OFF = LDSCTL_OFF + 320;
constexpr int LDS_BYTES = 147456;
constexpr int NWAVES = 8;

#define RLX_AGENT __ATOMIC_RELAXED, __HIP_MEMORY_SCOPE_AGENT
#define LDS_WAIT() asm volatile("s_waitcnt lgkmcnt(0)" ::: "memory")
#define VM_WAIT() asm volatile("s_waitcnt vmcnt(0)" ::: "memory")

__device__ __forceinline__ unsigned f2bf(float f) { unsigned u = __builtin_bit_cast(unsigned, f); return (u + 0x7fffu + ((u >> 16) & 1u)) >> 16; }
__device__ __forceinline__ unsigned pk2(float lo, float hi) { return f2bf(lo) | (f2bf(hi) << 16); }
__device__ __forceinline__ unsigned cvt_pk_bf16(float lo, float hi) { unsigned r; asm volatile("v_cvt_pk_bf16_f32 %0, %1, %2" : "=v"(r) : "v"(lo), "v"(hi)); return r; }
__device__ __forceinline__ unsigned pk4_fp8(float a, float b, float c, float d) { int r = 0; r = __builtin_amdgcn_cvt_pk_fp8_f32(a, b, r, false); r = __builtin_amdgcn_cvt_pk_fp8_f32(c, d, r, true); return (unsigned)r; }
__device__ __forceinline__ float bf_lo(unsigned v) { return __builtin_bit_cast(float, v << 16); }
__device__ __forceinline__ float bf_hi(unsigned v) { return __builtin_bit_cast(float, v & 0xffff0000u); }
__device__ __forceinline__ float sigmoidf_fast(float g) { return __builtin_amdgcn_rcpf(1.0f + __builtin_amdgcn_exp2f(-LOG2E * g)); }
__device__ __forceinline__ float wave_sum(float v) {
#pragma unroll
    for (int o = 1; o < 64; o <<= 1) v += __shfl_xor(v, o);
    return v;
}

#define XB_TMO      128
#define XB_XCNT(j)  (256  + 64 * (j))
#define XB_XSUB(j)  (1280 + 64 * (j))
#define XB_XGEN(j)  (2304 + 64 * (j))
#define XB_TOP      3328
#define XB_TOPGEN   3392
#define XCD_BAR_WORDS 3456
#define XB_SPIN_CAP (1u << 18)
__device__ __forceinline__ unsigned xb_ld(unsigned* p)              { return __hip_atomic_load(p, __ATOMIC_RELAXED, __HIP_MEMORY_SCOPE_AGENT); }
__device__ __forceinline__ unsigned xb_add(unsigned* p, unsigned v) { return __hip_atomic_fetch_add(p, v, __ATOMIC_RELAXED, __HIP_MEMORY_SCOPE_AGENT); }
__device__ __forceinline__ unsigned xb_xcc_id() { return (unsigned)__builtin_amdgcn_s_getreg((3 << 11) | 20) & 0xFu; }
#define XB_SPIN(cond, bar) do { unsigned _sp = 0; while (cond) { __builtin_amdgcn_s_sleep(1); \
    if ((++_sp & 255u) == 0u) { if (xb_ld(&(bar)[XB_TMO])) break; if (_sp > XB_SPIN_CAP) { atomicAdd(&(bar)[XB_TMO], 1u); break; } } } } while (0)
struct XcdBarrier { unsigned* bar; unsigned x; volatile LAS unsigned* st; };
__device__ __forceinline__ XcdBarrier xcd_barrier_post(unsigned* bar, volatile LAS unsigned* st) {
    XcdBarrier b; b.bar = bar; b.x = xb_xcc_id(); b.st = st;
    if (threadIdx.x == 0) (void)xb_add(&bar[XB_XCNT(b.x)], 1u);
    return b;
}
__device__ __forceinline__ void xcd_barrier_complete(unsigned* bar, unsigned x, unsigned& nloc, unsigned& nx) {
    const unsigned G = gridDim.x * gridDim.y * gridDim.z;
    unsigned sum, cnt, mine, sp = 0u;
    for (;;) {
        sum = 0u; cnt = 0u; mine = 0u;
#pragma unroll
        for (unsigned j = 0; j < 16; ++j) { const unsigned c = xb_ld(&bar[XB_XCNT(j)]); sum += c; cnt += (c > 0u) ? 1u : 0u; mine = (j == x) ? c : mine; }
        if (sum == G) break;
        __builtin_amdgcn_s_sleep(1);
        if ((++sp & 255u) == 0u) { if (xb_ld(&bar[XB_TMO])) break; if (sp > XB_SPIN_CAP) { atomicAdd(&bar[XB_TMO], 1u); break; } }
    }
    nloc = mine > 0u ? mine : 1u; nx = cnt > 0u ? cnt : 1u;
}
__device__ __forceinline__ void xcd_barrier(const XcdBarrier& b) {
    asm volatile("s_waitcnt vmcnt(0)" ::: "memory");
    __syncthreads();
    if (threadIdx.x == 0) {
        unsigned* bar = b.bar;
        __builtin_amdgcn_s_waitcnt(0);
        unsigned nloc = b.st[0], nx = b.st[1];
        if (nloc == 0u) { xcd_barrier_complete(bar, b.x, nloc, nx); b.st[0] = nloc; b.st[1] = nx; }
        const unsigned old = xb_add(&bar[XB_XSUB(b.x)], 1u);
        const unsigned gen = old / nloc;
        if (old + 1u == (gen + 1u) * nloc) {
            __builtin_amdgcn_fence(__ATOMIC_RELEASE, "agent");
            asm volatile("s_waitcnt vmcnt(0)" ::: "memory");
            const unsigned og = xb_add(&bar[XB_TOP], 1u);
            const unsigned tg = og / nx;
            if (og + 1u == (tg + 1u) * nx) xb_add(&bar[XB_TOPGEN], 1u);
            else XB_SPIN(xb_ld(&bar[XB_TOPGEN]) == tg, bar);
            __builtin_amdgcn_fence(__ATOMIC_ACQUIRE, "agent");
            xb_add(&bar[XB_XGEN(b.x)], 1u);
            asm volatile("s_waitcnt vmcnt(0)" ::: "memory");
        } else {
            XB_SPIN(xb_ld(&bar[XB_XGEN(b.x)]) == gen, bar);
            __builtin_amdgcn_fence(__ATOMIC_ACQUIRE, "agent");
            asm volatile("s_waitcnt vmcnt(0)" ::: "memory");
        }
    }
    __syncthreads();
}

namespace pg8 {
#define PG8_LAS __attribute__((address_space(3)))
constexpr int BM = 256, BK = 64, HALF = 128, HTB = HALF * BK * 2, STAGE_BYTES = 8 * HTB, NXCD = 8, WGM = 8;
__host__ __device__ __forceinline__ int lds_byte(int r, int c) { const int st = (r >> 4) * 2 + (c >> 5), rr = r & 15, cc = c & 31, ob = rr * 64 + cc * 2; return st * 1024 + (ob ^ (((ob >> 9) & 1) << 5)); }
__host__ __device__ __forceinline__ void stage_rc(int b, int& R, int& C) { const int st = b / 1024, sb = b % 1024, swz = sb ^ (((sb >> 9) & 1) << 5); R = (st >> 1) * 16 + swz / 64; C = (st & 1) * 32 + (swz % 64) / 2; }
__host__ __device__ __forceinline__ int perm32(int rho) { const int n = rho >> 4, i = rho & 15; return 8 * (i >> 2) + 4 * n + (i & 3); }

typedef int v4i_t __attribute__((ext_vector_type(4)));
typedef int v8i_t __attribute__((ext_vector_type(8)));
typedef float f32x8 __attribute__((ext_vector_type(8)));
struct Unit { const char* a; const char* b; int pm, pn, kind; };

__device__ __forceinline__ bool tile_order(long L, int nM, int nN, int& pm, int& pn) {
    const int nwg = nM * nN; if (L >= nwg) return false;
    int wgid = (int)L; { const int q = nwg / NXCD, r = nwg % NXCD, xcd = wgid % NXCD, off = wgid / NXCD; wgid = (xcd < r ? xcd * (q + 1) : r * (q + 1) + (xcd - r) * q) + off; }
    const int nig = WGM * nN, gid = wgid / nig, fm = gid * WGM, gsz = (nM - fm) < WGM ? (nM - fm) : WGM;
    pm = fm + ((wgid % nig) % gsz); pn = (wgid % nig) / gsz; return true;
}

template <class Epi, class Sched, bool ALIGN_EPI, bool FP8 = false>
__device__ __forceinline__ void gemm_phase(PG8_LAS unsigned char* lds, const int KB, const Sched& S, const Epi& E) {
    int tid_ = threadIdx.x; asm volatile("" : "+v"(tid_));
    const int tid = tid_, wid = __builtin_amdgcn_readfirstlane(tid >> 6), lane = tid & 63, wr = wid >> 2, wc = wid & 3, fr = lane & 15, fq = lane >> 4;
    const int nt = KB / 128;
    unsigned voffA[2], voffB[2];
#pragma unroll
    for (int i = 0; i < 2; ++i) { int R, C; stage_rc(tid * 16 + i * 8192, R, C); const int Rb = (R & ~31) + perm32(R & 31);
        voffA[i] = (unsigned)(R * KB + C * 2); voffB[i] = (unsigned)(Rb * KB + C * 2); }
    const size_t kstep = (size_t)(BK * 2);
    const size_t hstep = (size_t)HALF * KB;
    const unsigned ldsw = (unsigned)wid * 1024u;
    const int aoff = lds_byte(wr * 64 + fr, fq * 8), boff = lds_byte(wc * 32 + fr, fq * 8);
#define PG8_SA(b, h) (((b) * 2 + (h)) * HTB)
#define PG8_SB(b, h) ((4 + (b) * 2 + (h)) * HTB)
#define PG8_STAGE(bufoff, gbase, voff) do { _Pragma("unroll") for (int _i = 0; _i < 2; ++_i) \
        __builtin_amdgcn_global_load_lds((const unsigned*)((const char*)(gbase) + (voff)[_i]), (PG8_LAS unsigned*)(lds + (bufoff) + ldsw + _i * 8192), 16, 0, 0); } while (0)
#define PG8_RD(off) (*(const PG8_LAS v4i_t*)(lds + (off)))
#define PG8_LDA(dst, b, h) do { _Pragma("unroll") for (int m = 0; m < 4; ++m) { \
        if constexpr (FP8) dst##8[m] = __builtin_shufflevector(PG8_RD(PG8_SA(b, h) + aoff + m * 2048), PG8_RD(PG8_SA(b, h) + aoff + m * 2048 + 1024), 0, 1, 2, 3, 4, 5, 6, 7); \
        else { _Pragma("unroll") for (int k = 0; k < 2; ++k) dst[m][k] = *(const PG8_LAS bf16x8*)(lds + PG8_SA(b, h) + aoff + m * 2048 + k * 1024); } } } while (0)
#define PG8_LDB(dst, b, h) do { _Pragma("unroll") for (int n = 0; n < 2; ++n) { \
        if constexpr (FP8) dst##8[n] = __builtin_shufflevector(PG8_RD(PG8_SB(b, h) + boff + n * 2048), PG8_RD(PG8_SB(b, h) + boff + n * 2048 + 1024), 0, 1, 2, 3, 4, 5, 6, 7); \
        else { _Pragma("unroll") for (int k = 0; k < 2; ++k) dst[n][k] = *(const PG8_LAS bf16x8*)(lds + PG8_SB(b, h) + boff + n * 2048 + k * 1024); } } } while (0)
#define PG8_MMA(ai, bj, At, Bt) do { __builtin_amdgcn_s_setprio(1); \
        if constexpr (FP8) { _Pragma("unroll") for (int m = 0; m < 4; ++m) _Pragma("unroll") for (int n = 0; n < 2; ++n) \
            asm volatile("v_mfma_f32_16x16x128_f8f6f4 %0, %1, %2, %0" : "+v"(acc[ai][bj][m][n]) : "v"(Bt##8[n]), "v"(At##8[m])); } \
        else { _Pragma("unroll") for (int m = 0; m < 4; ++m) _Pragma("unroll") for (int n = 0; n < 2; ++n) _Pragma("unroll") for (int k = 0; k < 2; ++k) \
            acc[ai][bj][m][n] = __builtin_amdgcn_mfma_f32_16x16x32_bf16(Bt[n][k], At[m][k], acc[ai][bj][m][n], 0, 0, 0); } \
        __builtin_amdgcn_s_setprio(0); } while (0)
#define PG8_WAIT_V(n) asm volatile("s_waitcnt vmcnt(" #n ")" ::: "memory")
#define PG8_WAIT_L(n) asm volatile("s_waitcnt lgkmcnt(" #n ")" ::: "memory")
#define PG8_BAR __builtin_amdgcn_s_barrier()
#define PG8_SCHED __builtin_amdgcn_sched_barrier(0)
    Unit cur, nxt; int ui = 0;
    if (!S.next(0, cur)) return;
    f32x4 acc[2][2][4][2];
#pragma unroll
    for (int a = 0; a < 2; ++a)
#pragma unroll
        for (int b = 0; b < 2; ++b)
#pragma unroll
            for (int m = 0; m < 4; ++m)
#pragma unroll
                for (int n = 0; n < 2; ++n) acc[a][b][m][n] = (f32x4){0.f, 0.f, 0.f, 0.f};
    bf16x8 At[4][2], B0[2][2], B1[2][2]; v8i_t At8[4], B08[2], B18[2];
    const char* cA = cur.a; const char* cB = cur.b;
    PG8_STAGE(PG8_SB(0, 0), cB, voffB); PG8_STAGE(PG8_SB(0, 1), cB + hstep, voffB); PG8_STAGE(PG8_SA(0, 0), cA, voffA); PG8_STAGE(PG8_SA(0, 1), cA + hstep, voffA);
    if (wr == 1) PG8_BAR;
    PG8_WAIT_V(2); PG8_BAR;
    PG8_STAGE(PG8_SB(1, 0), cB + kstep, voffB); PG8_STAGE(PG8_SA(1, 0), cA + kstep, voffA); PG8_STAGE(PG8_SB(1, 1), cB + hstep + kstep, voffB);
    PG8_WAIT_V(6); PG8_BAR;
    for (;;) {
        const bool has_next = S.next(ui + 1, nxt);
        const char* nA = has_next ? nxt.a : cA; const char* nB = has_next ? nxt.b : cB;
#pragma nounroll
        for (int t = 0; t < nt; t += 2) {
            const bool last = (t == nt - 2);
            const char* a1 = cA + (size_t)(t + 1) * kstep;
            const char* a2 = last ? nA : cA + (size_t)(t + 2) * kstep; const char* b2 = last ? nB : cB + (size_t)(t + 2) * kstep;
            const char* a3 = a2 + kstep; const char* b3 = b2 + kstep;
            PG8_LDB(B0, 0, 0); PG8_LDB(B1, 0, 1); PG8_SCHED; PG8_LDA(At, 0, 0); PG8_STAGE(PG8_SA(1, 1), a1 + hstep, voffA);
            PG8_WAIT_V(8); PG8_WAIT_L(0); PG8_BAR; PG8_MMA(0, 0, At, B0); PG8_MMA(0, 1, At, B1); PG8_BAR; PG8_SCHED;
            PG8_LDA(At, 0, 1); PG8_STAGE(PG8_SB(0, 0), b2, voffB); PG8_STAGE(PG8_SB(0, 1), b2 + hstep, voffB); PG8_STAGE(PG8_SA(0, 0), a2, voffA);
            PG8_WAIT_V(8); PG8_WAIT_L(0); PG8_BAR; PG8_MMA(1, 0, At, B0); PG8_MMA(1, 1, At, B1); PG8_BAR; PG8_SCHED;
            PG8_LDB(B0, 1, 0); PG8_LDB(B1, 1, 1); PG8_SCHED; PG8_LDA(At, 1, 0); PG8_STAGE(PG8_SA(0, 1), a2 + hstep, voffA);
            PG8_WAIT_V(8); PG8_WAIT_L(0); PG8_BAR; PG8_MMA(0, 0, At, B0); PG8_MMA(0, 1, At, B1); PG8_BAR; PG8_SCHED;
            PG8_LDA(At, 1, 1); PG8_STAGE(PG8_SB(1, 0), b3, voffB); PG8_STAGE(PG8_SB(1, 1), b3 + hstep, voffB); PG8_STAGE(PG8_SA(1, 0), a3, voffA);
            PG8_WAIT_V(8); PG8_WAIT_L(0); PG8_BAR; PG8_MMA(1, 0, At, B0); PG8_MMA(1, 1, At, B1); PG8_BAR; PG8_SCHED;
        }
        if constexpr (ALIGN_EPI) { if (wr == 0) PG8_BAR; }
        if constexpr (FP8) asm volatile("s_nop 15\n\ts_nop 7" ::: "memory");
        E(acc, cur, wr, wc, fr, fq);
        if (!has_next) break;
#pragma unroll
        for (int a = 0; a < 2; ++a)
#pragma unroll
            for (int b = 0; b < 2; ++b)
#pragma unroll
                for (int m = 0; m < 4; ++m)
#pragma unroll
                    for (int n = 0; n < 2; ++n) acc[a][b][m][n] = (f32x4){0.f, 0.f, 0.f, 0.f};
        cur = nxt; cA = nA; cB = nB; ++ui;
        if constexpr (ALIGN_EPI) { if (wr == 1) PG8_BAR; }
    }
    PG8_WAIT_V(0);
    if constexpr (!ALIGN_EPI) { if (wr == 0) PG8_BAR; }
    PG8_BAR;
#undef PG8_SA
#undef PG8_SB
#undef PG8_STAGE
#undef PG8_LDA
#undef PG8_LDB
#undef PG8_MMA
#undef PG8_RD
#undef PG8_WAIT_V
#undef PG8_WAIT_L
#undef PG8_BAR
#undef PG8_SCHED
}

typedef const f32x4 (&AccRef)[2][2][4][2];
typedef const f32x8 (&Acc8Ref)[2][2][4];
struct RowScale {
    const float* ssq; const float* direct;
    __device__ __forceinline__ float get(int row, int fq) const {
        if (direct) return direct[row];
        const f32x4 p = *(const f32x4*)(ssq + (size_t)row * 16 + fq * 4);
        float s = (p[0] + p[1]) + (p[2] + p[3]); s += __shfl_xor(s, 16); s += __shfl_xor(s, 32);
        return rsqrtf(s * (1.0f / D) + RMS_EPS);
    }
};
template <bool SIGB>
__device__ __forceinline__ void epi_glu(AccRef acc, const RowScale& R, const float* b0, const float* b1, bf16_t* out, int ld, int row0, int ch0, int fq) {
    f32x4 ba[2], bg[2];
#pragma unroll
    for (int n = 0; n < 2; ++n) { ba[n] = SIGB ? *(const f32x4*)(b0 + ch0 + 4 * n) : (f32x4){0.f, 0.f, 0.f, 0.f}; bg[n] = SIGB ? *(const f32x4*)(b1 + ch0 + 4 * n) : (f32x4){0.f, 0.f, 0.f, 0.f}; }
#pragma unroll
    for (int ai = 0; ai < 2; ++ai)
#pragma unroll
        for (int m = 0; m < 4; ++m) {
            const int row = row0 + ai * HALF + m * 16; const float r = R.get(row, fq); f32x4 o[2];
#pragma unroll
            for (int n = 0; n < 2; ++n) {
                f32x4 a = acc[ai][0][m][n] * r + ba[n], g = acc[ai][1][m][n] * r + bg[n];
#pragma unroll
                for (int j = 0; j < 4; ++j) o[n][j] = SIGB ? a[j] * sigmoidf_fast(g[j]) : a[j] * sigmoidf_fast(a[j]) * g[j];
            }
            u32x4 w; w.x = cvt_pk_bf16(o[0][0], o[0][1]); w.y = cvt_pk_bf16(o[0][2], o[0][3]); w.z = cvt_pk_bf16(o[1][0], o[1][1]); w.w = cvt_pk_bf16(o[1][2], o[1][3]);
            *(u32x4*)(out + (size_t)row * ld + ch0) = w;
            asm volatile("" ::: "memory");
        }
}
__device__ __forceinline__ void epi_head(AccRef acc, const RowScale& R, const float* gain, float scale, bf16_t* out, int ld, int row0, int col0, int fq) {
    f32x4 gv[2][2];
#pragma unroll
    for (int bj = 0; bj < 2; ++bj)
#pragma unroll
        for (int n = 0; n < 2; ++n) gv[bj][n] = gain ? *(const f32x4*)(gain + 32 * bj + 8 * fq + 4 * n) * scale : (f32x4){1.f, 1.f, 1.f, 1.f};
#pragma unroll
    for (int ai = 0; ai < 2; ++ai)
#pragma unroll
        for (int m = 0; m < 4; ++m) {
            const int row = row0 + ai * HALF + m * 16; const float r = R.get(row, fq); f32x4 v[2][2]; float ss = 0.f;
#pragma unroll
            for (int bj = 0; bj < 2; ++bj)
#pragma unroll
                for (int n = 0; n < 2; ++n) { v[bj][n] = acc[ai][bj][m][n] * r; const f32x4 q = v[bj][n] * v[bj][n]; ss += (q[0] + q[1]) + (q[2] + q[3]); }
            ss += __shfl_xor(ss, 16); ss += __shfl_xor(ss, 32);
            const float rinv = gain ? rsqrtf(ss * (1.0f / 64.0f) + RMS_EPS) : 1.0f;
#pragma unroll
            for (int bj = 0; bj < 2; ++bj) {
                const f32x4 x0 = v[bj][0] * rinv * gv[bj][0], x1 = v[bj][1] * rinv * gv[bj][1];
                u32x4 w; w.x = cvt_pk_bf16(x0[0], x0[1]); w.y = cvt_pk_bf16(x0[2], x0[3]); w.z = cvt_pk_bf16(x1[0], x1[1]); w.w = cvt_pk_bf16(x1[2], x1[3]);
                *(u32x4*)(out + (size_t)row * ld + col0 + 32 * bj + 8 * fq) = w;
            }
            asm volatile("" ::: "memory");
        }
}
__device__ __forceinline__ void epi_resid(AccRef acc, const float* res, float* outf, bf16_t* outb, float* ssq, int row0, int col0, int slot, int fq) {
#pragma unroll
    for (int ai = 0; ai < 2; ++ai)
#pragma unroll
        for (int m = 0; m < 4; ++m) {
            const size_t ro = (size_t)(row0 + ai * HALF + m * 16) * D + col0; float ss = 0.f;
#pragma unroll
            for (int bj = 0; bj < 2; ++bj) {
                const f32x4 o0 = *(const f32x4*)(res + ro + bj * HALF) + acc[ai][bj][m][0], o1 = *(const f32x4*)(res + ro + bj * HALF + 4) + acc[ai][bj][m][1];
                const f32x4 q0 = o0 * o0, q1 = o1 * o1; ss += ((q0[0] + q0[1]) + (q0[2] + q0[3])) + ((q1[0] + q1[1]) + (q1[2] + q1[3]));
                *(f32x4*)(outf + ro + bj * HALF) = o0; *(f32x4*)(outf + ro + bj * HALF + 4) = o1;
                u32x4 w; w.x = cvt_pk_bf16(o0[0], o0[1]); w.y = cvt_pk_bf16(o0[2], o0[3]); w.z = cvt_pk_bf16(o1[0], o1[1]); w.w = cvt_pk_bf16(o1[2], o1[3]);
                *(u32x4*)(outb + ro + bj * HALF) = w;
            }
            ss += __shfl_xor(ss, 16); ss += __shfl_xor(ss, 32);
            if (fq == 0) ssq[(size_t)(row0 + ai * HALF + m * 16) * 16 + slot] = ss;
            asm volatile("" ::: "memory");
        }
}
}

struct Args { const float* in[30]; float* out; unsigned char* ws; int ph_lo, ph_hi; };
struct Frame {
    LAS unsigned char* lds;
    volatile LAS unsigned* MISC;
    gu32* ctl;
    int tid, lane, wave, G;
    unsigned char* ws;
    float* out;
};
enum InIdx { I_X = 0, I_MEM, I_MEM_NORM_G, I_W_MEM_KV, I_MEM_K_NORM_G, I_CV_ATTN_NORM_G, I_CV_W_IN, I_CV_B_GLU, I_CV_DW_W, I_CV_DW_B, I_CV_LN_G, I_CV_LN_B,
             I_CV_MEMQ_NORM_G, I_CV_W_OUT, I_CV_FFN_NORM_G, I_CV_W_GATE, I_CV_W_UP, I_CV_W_DOWN, I_SW_ATTN_NORM_G, I_SW_W_IN, I_SW_Q_NORM_G, I_SW_K_NORM_G,
             I_SW_SINKS, I_SW_MEMQ_NORM_G, I_SW_W_OUT, I_SW_FFN_NORM_G, I_SW_ROUTER, I_SW_WE_GATE, I_SW_WE_UP, I_SW_WE_DOWN };

__device__ __forceinline__ void tr_item(const float* W, int N, int Kd, bf16* WT, int k0, int n0, int dst_row0, const float* gain, LAS float* scr, int lane) {
#pragma unroll 8
    for (int i = 0; i < 32; ++i) { const int kk = 2 * i + (lane >> 5); scr[kk * 33 + (lane & 31)] = W[(size_t)(k0 + kk) * N + n0 + (lane & 31)]; }
    LDS_WAIT(); asm volatile("" ::: "memory");
    const int c = lane & 7;
    f32x4 g0 = (f32x4){1.f, 1.f, 1.f, 1.f}, g1 = g0;
    if (gain) { g0 = *(const f32x4*)(gain + k0 + 8 * c); g1 = *(const f32x4*)(gain + k0 + 8 * c + 4); }
#pragma unroll
    for (int j = 0; j < 4; ++j) { const int n = (lane >> 3) + 8 * j; const LAS float* s = scr + (8 * c) * 33 + n;
        u32x4 o; o.x = pk2(s[0 * 33] * g0[0], s[1 * 33] * g0[1]); o.y = pk2(s[2 * 33] * g0[2], s[3 * 33] * g0[3]); o.z = pk2(s[4 * 33] * g1[0], s[5 * 33] * g1[1]); o.w = pk2(s[6 * 33] * g1[2], s[7 * 33] * g1[3]);
        *(u32x4*)(WT + (size_t)(dst_row0 + n) * Kd + k0 + 8 * c) = o; }
    LDS_WAIT(); asm volatile("" ::: "memory");
}
__device__ __forceinline__ void tr_item8(const float* W, int N, int Kd, unsigned char* WT, int k0, int n0, int dst_row0, const float* gain, float scale, LAS float* scr, int lane) {
#pragma unroll 8
    for (int i = 0; i < 32; ++i) { const int kk = 2 * i + (lane >> 5); scr[kk * 33 + (lane & 31)] = __builtin_nontemporal_load(W + (size_t)(k0 + kk) * N + n0 + (lane & 31)); }
    LDS_WAIT(); asm volatile("" ::: "memory");
    const int c = lane & 3;
    f32x4 g[4];
#pragma unroll
    for (int q = 0; q < 4; ++q) g[q] = gain ? *(const f32x4*)(gain + k0 + 16 * c + 4 * q) * scale : (f32x4){scale, scale, scale, scale};
#pragma unroll
    for (int j = 0; j < 2; ++j) { const int n = (lane >> 2) + 16 * j; const LAS float* sp = scr + (16 * c) * 33 + n; u32x4 o;
#pragma unroll
        for (int q = 0; q < 4; ++q) o[q] = pk4_fp8(sp[(4 * q + 0) * 33] * g[q][0], sp[(4 * q + 1) * 33] * g[q][1], sp[(4 * q + 2) * 33] * g[q][2], sp[(4 * q + 3) * 33] * g[q][3]);
        *(u32x4*)(WT + (size_t)(dst_row0 + n) * Kd + k0 + 16 * c) = o; }
    LDS_WAIT(); asm volatile("" ::: "memory");
}
__device__ __forceinline__ int map_glu(int ch, int part) { return 256 * (ch >> 7) + 128 * part + (ch & 127); }
__device__ __forceinline__ int map_head(int n) { return 256 * (n >> 8) + 128 * ((n >> 5) & 1) + 32 * ((n >> 6) & 3) + (n & 31); }

__device__ __forceinline__ void row_to_bf16_ssq(const float* xrow, bf16* orow, float* ssq, int lane) {
    const f32x4* xr = (const f32x4*)xrow + lane;
    f32x4 v[4]; float s = 0.f;
#pragma unroll
    for (int j = 0; j < 4; ++j) { v[j] = xr[64 * j]; s += (v[j][0] * v[j][0] + v[j][1] * v[j][1]) + (v[j][2] * v[j][2] + v[j][3] * v[j][3]); }
    s = wave_sum(s);
    u32x2* o8 = (u32x2*)orow + lane;
#pragma unroll
    for (int j = 0; j < 4; ++j) { u32x2 w; w.x = pk2(v[j][0], v[j][1]); w.y = pk2(v[j][2], v[j][3]); o8[64 * j] = w; }
    if (lane < 16) ssq[lane] = (lane == 0) ? s : 0.f;
}

__device__ __forceinline__ void p0_prologue(Frame& F, const Args& A) {
    LAS float* scr = (LAS float*)(F.lds + F.wave * 16384);
    const int gw = blockIdx.x * NWAVES + F.wave, NGW = F.G * NWAVES, lane = F.lane;
    unsigned char* ws = F.ws;
    constexpr int I0 = 16 * (N_IN0 / 32);
    constexpr int I1 = I0 + 16 * 32;
    constexpr int I2 = I1 + 16 * (FF / 32);
    constexpr int I3 = I2 + 16 * (FF / 32);
    constexpr int I4 = I3 + (FF / 64) * 32;
    constexpr int I5 = I4 + 16 * (N_IN1 / 32);
    constexpr int I6 = I5 + 16 * 32;
    constexpr int I7 = I6 + 16 * 16;
    for (int it = gw; it < I7; it += NGW) {
        if (it < I0) { const int r = it, nb = r % (N_IN0 / 32), kb = r / (N_IN0 / 32), n0 = nb * 32;
            const int dr = n0 < 768 ? map_glu(n0, 0) : (n0 < 1536 ? map_glu(n0 - 768, 1) : 1536 + map_head(n0 - 1536));
            tr_item(A.in[I_CV_W_IN], N_IN0, D, (bf16*)(ws + WS_WIN0), kb * 64, n0, dr, A.in[I_CV_ATTN_NORM_G], scr, lane); }
        else if (it < I1) { const int r = it - I0, nb = r % 32, kb = r / 32; tr_item(A.in[I_CV_W_OUT], D, D, (bf16*)(ws + WS_WOUT0), kb * 64, nb * 32, nb * 32, nullptr, scr, lane); }
        else if (it < I2) { const int r = it - I1, nb = r % (FF / 32), kb = r / (FF / 32); tr_item(A.in[I_CV_W_GATE], FF, D, (bf16*)(ws + WS_WGU0), kb * 64, nb * 32, map_glu(nb * 32, 0), A.in[I_CV_FFN_NORM_G], scr, lane); }
        else if (it < I3) { const int r = it - I2, nb = r % (FF / 32), kb = r / (FF / 32); tr_item(A.in[I_CV_W_UP], FF, D, (bf16*)(ws + WS_WGU0), kb * 64, nb * 32, map_glu(nb * 32, 1), A.in[I_CV_FFN_NORM_G], scr, lane); }
        else if (it < I4) { const int r = it - I3, nb = r % 32, kb = r / 32; tr_item(A.in[I_CV_W_DOWN], D, FF, (bf16*)(ws + WS_WDN0), kb * 64, nb * 32, nb * 32, nullptr, scr, lane); }
        else if (it < I5) { const int r = it - I4, nb = r % (N_IN1 / 32), kb = r / (N_IN1 / 32); tr_item(A.in[I_SW_W_IN], N_IN1, D, (bf16*)(ws + WS_WIN1), kb * 64, nb * 32, map_head(nb * 32), A.in[I_SW_ATTN_NORM_G], scr, lane); }
        else if (it < I6) { const int r = it - I5, nb = r % 32, kb = r / 32; tr_item(A.in[I_SW_W_OUT], D, D, (bf16*)(ws + WS_WOUT1), kb * 64, nb * 32, nb * 32, nullptr, scr, lane); }
        else { const int r = it - I6, nb = r % 16, kb = r / 16; tr_item(A.in[I_W_MEM_KV], 512, D, (bf16*)(ws + WS_WMKV), kb * 64, nb * 32, map_head(nb * 32), A.in[I_MEM_NORM_G], scr, lane); }
    }
    for (int m = gw; m < M; m += NGW) row_to_bf16_ssq(A.in[I_X] + (size_t)m * D, (bf16*)(ws + WS_HB) + (size_t)m * D, (float*)(ws + WS_SSQ) + (size_t)m * 16, lane);
    for (int m = gw; m < MEM_ROWS; m += NGW) row_to_bf16_ssq(A.in[I_MEM] + (size_t)m * D, (bf16*)(ws + WS_MEMB) + (size_t)m * D, (float*)(ws + WS_SSQM) + (size_t)m * 16, lane);
}

constexpr int MOE_PER_E = 16 * (FE / 32);
constexpr int MOE_ITEMS = 3 * NE * MOE_PER_E;
constexpr int CV_CHUNK = 16, CV_NCHUNK = MOE_ITEMS / CV_CHUNK;
static_assert(MOE_ITEMS % CV_CHUNK == 0, "chunks");
struct CvtItem { const float* W; unsigned char* WT; const float* gain; int N, Kd, k0, n0, dr; float scale; };
__device__ __forceinline__ CvtItem moe_cvt_decode(Frame& F, const Args& A, int r) {
    unsigned char* ws = F.ws; CvtItem it;
    if (r < 2 * NE * MOE_PER_E) { const bool up = r >= NE * MOE_PER_E; const int rr = up ? r - NE * MOE_PER_E : r, e = rr / MOE_PER_E, q = rr % MOE_PER_E, nb = q % (FE / 32), kb = q / (FE / 32);
        it.W = A.in[up ? I_SW_WE_UP : I_SW_WE_GATE] + (size_t)e * D * FE; it.N = FE; it.Kd = D; it.WT = ws + WS_WGUE + (size_t)e * 2 * FE * D; it.k0 = kb * 64; it.n0 = nb * 32; it.dr = map_glu(nb * 32, up ? 1 : 0); it.gain = A.in[I_SW_FFN_NORM_G]; it.scale = S_W; }
    else { const int rr = r - 2 * NE * MOE_PER_E, e = rr / MOE_PER_E, q = rr % MOE_PER_E, nb = q % 32, kb = q / 32;
        it.W = A.in[I_SW_WE_DOWN] + (size_t)e * FE * D; it.N = D; it.Kd = FE; it.WT = ws + WS_WDNE + (size_t)e * D * FE; it.k0 = kb * 64; it.n0 = nb * 32; it.dr = nb * 32; it.gain = nullptr; it.scale = S_WD; }
    return it;
}
__device__ __forceinline__ void cvt_load(const CvtItem& it, f32x4 (&v)[8], int lane) {
    const float* p = it.W + (size_t)(it.k0 + (lane >> 3)) * it.N + it.n0 + 4 * (lane & 7);
#pragma unroll
    for (int i = 0; i < 8; ++i) v[i] = __builtin_nontemporal_load((const f32x4*)(p + (size_t)(8 * i) * it.N));
}
__device__ __forceinline__ void cvt_emit(const CvtItem& it, const f32x4 (&v)[8], LAS float* scr, int lane) {
#pragma unroll
    for (int i = 0; i < 8; ++i) *(LAS f32x4*)(scr + ((lane >> 3) + 8 * i) * 36 + 4 * (lane & 7)) = v[i];
    LDS_WAIT(); asm volatile("" ::: "memory");
    const int n = lane & 31;
#pragma unroll
    for (int j = 0; j < 2; ++j) { const int ch = (lane >> 5) + 2 * j; const LAS float* sp = scr + (16 * ch) * 36 + n; u32x4 o;
#pragma unroll
        for (int q = 0; q < 4; ++q) { f32x4 g = (f32x4){it.scale, it.scale, it.scale, it.scale}; if (it.gain) g = *(const f32x4*)(it.gain + it.k0 + 16 * ch + 4 * q) * it.scale;
            o[q] = pk4_fp8(sp[(4 * q + 0) * 36] * g[0], sp[(4 * q + 1) * 36] * g[1], sp[(4 * q + 2) * 36] * g[2], sp[(4 * q + 3) * 36] * g[3]); }
        *(u32x4*)(it.WT + (size_t)(it.dr + n) * it.Kd + it.k0 + 16 * ch) = o; }
    LDS_WAIT(); asm volatile("" ::: "memory");
}
__device__ __forceinline__ void steal_convert(Frame& F, const Args& A, int k) {
    LAS float* scr = (LAS float*)(F.lds + F.wave * 16384);
    volatile LAS int* slot = (volatile LAS int*)(F.lds + LDSCTL_OFF + 64);
    __syncthreads();
    if (k >= 0 && F.tid == 0) __hip_atomic_fetch_add(F.ctl + CW_DONE + 64 * k, 1u, RLX_AGENT);
    for (;;) {
        if (F.tid == 0) { int idx = -1; bool go = true;
            if (k >= 0) go = __hip_atomic_load(F.ctl + CW_DONE + 64 * k, RLX_AGENT) < (unsigned)F.G;
            if (go) { const unsigned cidx = __hip_atomic_fetch_add(F.ctl + CW_STEAL, 1u, RLX_AGENT); if (cidx < (unsigned)CV_NCHUNK) idx = (int)cidx; }
            *slot = idx; }
        __syncthreads();
        const int idx = *slot;
        __syncthreads();
        if (idx < 0) break;
        const CvtItem ia = moe_cvt_decode(F, A, idx * CV_CHUNK + F.wave * 2), ib = moe_cvt_decode(F, A, idx * CV_CHUNK + F.wave * 2 + 1);
        f32x4 va[8], vb[8]; cvt_load(ia, va, F.lane); cvt_load(ib, vb, F.lane);
        cvt_emit(ia, va, scr, F.lane); cvt_emit(ib, vb, scr, F.lane);
    }
}

using pg8::Unit; using pg8::f32x8;
struct DenseSched {
    const char* A; const char* Bt; int nM, nN, KB, G, c;
    __device__ __forceinline__ bool next(int i, Unit& u) const {
        const long L = (long)i * G + c; int pm, pn;
        if (!pg8::tile_order(L, nM, nN, pm, pn)) return false;
        u.pm = pm; u.pn = pn; u.kind = 0; u.a = A + (size_t)pm * 256 * KB; u.b = Bt + (size_t)pn * 256 * KB; return true;
    }
};
struct Dense2Sched {
    const char* A; const char* Bt; int nM, nN, KB, G, c; const char* A2; const char* B2;
    __device__ __forceinline__ bool next(int i, Unit& u) const {
        const long L = (long)i * G + c; const int nwg = nM * nN;
        if (L >= nwg + 4) return false;
        if (L < nwg) { int pm, pn; pg8::tile_order(L, nM, nN, pm, pn); u.pm = pm; u.pn = pn; u.kind = 0; u.a = A + (size_t)pm * 256 * KB; u.b = Bt + (size_t)pn * 256 * KB; }
        else { const int r = (int)(L - nwg); u.pm = r >> 1; u.pn = r & 1; u.kind = 1; u.a = A2 + (size_t)u.pm * 256 * KB; u.b = B2 + (size_t)u.pn * 256 * KB; }
        return true;
    }
};
struct MoeSched {
    const char* A; const char* W; int nN, KB, G, c; int ts1, ts2, ts3, ts4, ts5, ts6, ts7, ts8; size_t wstride; int x, r0;
    __device__ __forceinline__ void init_counts(const gu32* cnt, int pass) {
        int t = 0; int s[9]; s[0] = 0;
#pragma unroll
        for (int e = 0; e < 8; ++e) { const int c0 = (int)__hip_atomic_load(cnt + e * 64, RLX_AGENT), c1 = (int)__hip_atomic_load(cnt + (8 + e) * 64, RLX_AGENT);
            t += pass == 0 ? (c0 + (c1 & 255) + 255) >> 8 : c1 >> 8; s[e + 1] = t; }
        ts1 = s[1]; ts2 = s[2]; ts3 = s[3]; ts4 = s[4]; ts5 = s[5]; ts6 = s[6]; ts7 = s[7]; ts8 = s[8]; x = 0; r0 = 0;
    }
    __device__ __forceinline__ bool next(int i, Unit& u) const {
        const int nB = G - x;
        const long L = (c >= x) ? (i < r0 ? (long)i * nB + (c - x) : (long)r0 * nB + (long)(i - r0) * G + c) : (long)r0 * nB + (long)i * G + c;
        int pm, pn; if (!pg8::tile_order(L, ts8, nN, pm, pn)) return false;
        const int e = (pm >= ts1) + (pm >= ts2) + (pm >= ts3) + (pm >= ts4) + (pm >= ts5) + (pm >= ts6) + (pm >= ts7);
        u.pm = pm; u.pn = pn; u.kind = e; u.a = A + (size_t)pm * 256 * KB; u.b = W + (size_t)e * wstride + (size_t)pn * 256 * KB; return true;
    }
};

struct EpiInProj0 {
    const float* ssq; const float* ssqm; const float* b_glu; const float* memq_g; const float* memk_g; bf16* U; bf16* QM; bf16* MK; bf16* MV;
    __device__ __forceinline__ void operator()(pg8::AccRef acc, const Unit& u, int wr, int wc, int fr, int fq) const {
        const int row0 = u.pm * 256 + wr * 64 + fr;
        if (u.kind == 0) { const pg8::RowScale R{ssq, nullptr};
            if (u.pn < 6) pg8::epi_glu<true>(acc, R, b_glu, b_glu + CONV_CH, U, CONV_CH, row0, u.pn * 128 + wc * 32 + fq * 8, fq);
            else pg8::epi_head(acc, R, memq_g, QSCALE, QM, 256, row0, wc * 64, fq);
        } else { const pg8::RowScale R{ssqm, nullptr};
            if (u.pn == 0) pg8::epi_head(acc, R, memk_g, 1.0f, MK, 256, row0, wc * 64, fq);
            else pg8::epi_head(acc, R, nullptr, 1.0f, MV, 256, row0, wc * 64, fq);
        }
    }
};
struct EpiInProj1 {
    const float* ssq; const float* q_g; const float* k_g; const float* memq_g; bf16* Q; bf16* Kb; bf16* Vb; bf16* QM;
    __device__ __forceinline__ void operator()(pg8::AccRef acc, const Unit& u, int wr, int wc, int fr, int fq) const {
        const int row0 = u.pm * 256 + wr * 64 + fr; const pg8::RowScale R{ssq, nullptr};
        if (u.pn < 3) pg8::epi_head(acc, R, q_g, QSCALE, Q, 768, row0, u.pn * 256 + wc * 64, fq);
        else if (u.pn == 3) pg8::epi_head(acc, R, k_g, 1.0f, Kb, 256, row0, wc * 64, fq);
        else if (u.pn == 4) pg8::epi_head(acc, R, nullptr, 1.0f, Vb, 256, row0, wc * 64, fq);
        else pg8::epi_head(acc, R, memq_g, QSCALE, QM, 256, row0, wc * 64, fq);
    }
};
struct EpiResid {
    const float* res; float* outf; bf16* outb; float* ssq;
    __device__ __forceinline__ void operator()(pg8::AccRef acc, const Unit& u, int wr, int wc, int fr, int fq) const {
        pg8::epi_resid(acc, res, outf, outb, ssq, u.pm * 256 + wr * 64 + fr, u.pn * 256 + wc * 32 + fq * 8, u.pn * 4 + wc, fq);
    }
};
struct EpiSwiglu {
    const float* ssq; const float* rowr; bf16* act; int ld;
    __device__ __forceinline__ void operator()(pg8::AccRef acc, const Unit& u, int wr, int wc, int fr, int fq) const {
        const int row0 = u.pm * 256 + wr * 64 + fr; const pg8::RowScale R{ssq, rowr};
        pg8::epi_glu<false>(acc, R, nullptr, nullptr, act, ld, row0, u.pn * 128 + wc * 32 + fq * 8, fq);
    }
};
struct EpiSwiglu8 {
    unsigned char* act;
    __device__ __forceinline__ void operator()(pg8::AccRef acc, const Unit& u, int wr, int wc, int fr, int fq) const {
        const int row0 = u.pm * 256 + wr * 64 + fr, ch0 = u.pn * 128 + wc * 32 + fq * 8; constexpr float inv = 1.0f / (S_X * S_W);
#pragma unroll
        for (int ai = 0; ai < 2; ++ai)
#pragma unroll
            for (int m = 0; m < 4; ++m) { f32x4 o[2];
#pragma unroll
                for (int n = 0; n < 2; ++n) { const f32x4 g = acc[ai][0][m][n] * inv, v = acc[ai][1][m][n] * (inv * S_A);
#pragma unroll
                    for (int j = 0; j < 4; ++j) o[n][j] = g[j] * sigmoidf_fast(g[j]) * v[j]; }
                u32x2 w; w.x = pk4_fp8(o[0][0], o[0][1], o[0][2], o[0][3]); w.y = pk4_fp8(o[1][0], o[1][1], o[1][2], o[1][3]);
                *(u32x2*)(act + (size_t)(row0 + ai * 128 + m * 16) * FE + ch0) = w; }
    }
};
struct EpiMoeDown {
    const int* rowtok; const float* rowg; float* out; float gmul;
    __device__ __forceinline__ void operator()(pg8::AccRef acc, const Unit& u, int wr, int wc, int fr, int fq) const {
        const int row0 = u.pm * 256 + wr * 64 + fr, col0 = u.pn * 256 + wc * 32 + fq * 8;
#pragma unroll
        for (int ai = 0; ai < 2; ++ai)
#pragma unroll
            for (int m = 0; m < 4; ++m) {
                const int r = row0 + ai * 128 + m * 16; const int tk = rowtok[r];
                if (tk >= 0) { const float g = rowg[r] * (1.0f / (S_A * S_WD)) * gmul; float* op = out + (size_t)(tk & (TOK_ATOMIC - 1)) * D + col0;
                    if (tk & TOK_ATOMIC) {
#pragma unroll
                        for (int bj = 0; bj < 2; ++bj)
#pragma unroll
                            for (int n = 0; n < 2; ++n)
#pragma unroll
                                for (int j = 0; j < 4; ++j) unsafeAtomicAdd(op + bj * 128 + 4 * n + j, acc[ai][bj][m][n][j] * g);
                    } else {
#pragma unroll
                        for (int bj = 0; bj < 2; ++bj)
#pragma unroll
                            for (int n = 0; n < 2; ++n) { f32x4 t = *(const f32x4*)(op + bj * 128 + 4 * n); t += acc[ai][bj][m][n] * g; *(f32x4*)(op + bj * 128 + 4 * n) = t; } } }
            }
    }
};

struct ConvCtx { float w0[CONV_W], w1[CONV_W]; float b0, b1; };
constexpr int CV_C = 73728;
__device__ __forceinline__ void conv_unit(Frame& F, const ConvCtx& C, const bf16* U, bf16* MIX, const float* ln_g, const float* ln_b, int tile) {
    constexpr int TT = 16, ROWS = TT + CONV_W - 1;
    const int tok0 = tile * TT, b = tok0 / SEQ, s0 = tok0 % SEQ, tid = F.tid, lane = F.lane;
    LAS u32x4* l16 = (LAS u32x4*)F.lds;
    LAS unsigned* l4 = (LAS unsigned*)F.lds;
    LAS float* cres = (LAS float*)(F.lds + CV_C);
    __syncthreads();
    for (int idx = tid; idx < ROWS * 96; idx += NWAVES * 64) { const int r = idx / 96, c16 = idx % 96, s = s0 - (CONV_W - 1) + r;
        u32x4 v = (u32x4){0u, 0u, 0u, 0u}; if (s >= 0) v = *(const u32x4*)(U + ((size_t)b * SEQ + s) * CONV_CH + c16 * 8);
        l16[idx] = v; }
    __syncthreads();
    if (tid < 384) {
        float a0[TT], a1[TT];
#pragma unroll
        for (int t = 0; t < TT; ++t) { a0[t] = C.b0; a1[t] = C.b1; }
#pragma unroll
        for (int i = 0; i < ROWS; ++i) { const unsigned v = l4[i * 384 + tid]; const float x0 = bf_lo(v), x1 = bf_hi(v);
#pragma unroll
            for (int t = 0; t < TT; ++t) { const int j = i - t; if (j >= 0 && j < CONV_W) { a0[t] = fmaf(x0, C.w0[j], a0[t]); a1[t] = fmaf(x1, C.w1[j], a1[t]); } }
            if ((i & 3) == 3) __builtin_amdgcn_sched_barrier(0); }
#pragma unroll
        for (int t = 0; t < TT; ++t) *(LAS f32x2*)(cres + t * CONV_CH + 2 * tid) = (f32x2){a0[t], a1[t]};
    }
    __syncthreads();
#pragma unroll
    for (int tt = 0; tt < 2; ++tt) { const int t = 2 * F.wave + tt; f32x4 v[3]; float s1 = 0.f;
#pragma unroll
        for (int j = 0; j < 3; ++j) { v[j] = *(const LAS f32x4*)(cres + t * CONV_CH + 256 * j + 4 * lane); s1 += (v[j][0] + v[j][1]) + (v[j][2] + v[j][3]); }
        const float mean = wave_sum(s1) * (1.0f / CONV_CH); float s2 = 0.f;
#pragma unroll
        for (int j = 0; j < 3; ++j) { v[j] = v[j] - mean; const f32x4 q = v[j] * v[j]; s2 += (q[0] + q[1]) + (q[2] + q[3]); }
        const float rstd = rsqrtf(wave_sum(s2) * (1.0f / CONV_CH) + LN_EPS);
#pragma unroll
        for (int j = 0; j < 3; ++j) { const f32x4 g = *(const f32x4*)(ln_g + 256 * j + 4 * lane), bb = *(const f32x4*)(ln_b + 256 * j + 4 * lane);
            f32x4 y = v[j] * rstd * g + bb;
#pragma unroll
            for (int e = 0; e < 4; ++e) y[e] = y[e] * sigmoidf_fast(y[e]);
            u32x2 w; w.x = pk2(y[0], y[1]); w.y = pk2(y[2], y[3]);
            *(u32x2*)(MIX + (size_t)(tok0 + t) * D + 256 * j + 4 * lane) = w; }
    }
}

constexpr int AT_KS = 272 * 16, AT_VS = 272 * 32, AT_K = 0, AT_V = 8 * AT_KS;
__device__ __forceinline__ void attn_zero_pads(Frame& F) {
    __syncthreads();
    if (F.tid < 128) { const int c = F.tid >> 4, k = F.tid & 15; *(LAS u32x4*)(F.lds + AT_K + c * AT_KS + (256 + k) * 16) = (u32x4){0u, 0u, 0u, 0u}; }
    else if (F.tid < 256) { const int t = F.tid - 128, dq = t >> 5, h = t & 31; *(LAS u32x4*)(F.lds + AT_V + dq * AT_VS + 256 * 32 + h * 16) = (u32x4){0u, 0u, 0u, 0u}; }
    __syncthreads();
}
__device__ __forceinline__ void attn_load_kv(Frame& F, const bf16* Ks, const bf16* Vs, int pitch, int rowA, int rowB, int col0) {
    const int lane = F.lane, w = F.wave;
#pragma unroll
    for (int i = 0; i < 4; ++i) { const int p = w + 8 * i, c = p & 7, kq = p >> 3, key = 64 * kq + lane; const int row = key < 128 ? rowA + key : rowB + key - 128;
        __builtin_amdgcn_global_load_lds((const unsigned*)(Ks + (size_t)row * pitch + col0 + 8 * c), (LAS unsigned*)(F.lds + AT_K + c * AT_KS + kq * 1024), 16, 0, 0); }
#pragma unroll
    for (int i = 0; i < 4; ++i) { const int p = w + 8 * i, dq = p & 3, kg = p >> 2, key = 32 * kg + (lane >> 1); const int row = key < 128 ? rowA + key : rowB + key - 128;
        __builtin_amdgcn_global_load_lds((const unsigned*)(Vs + (size_t)row * pitch + col0 + 16 * dq + 8 * (lane & 1)), (LAS unsigned*)(F.lds + AT_V + dq * AT_VS + kg * 1024), 16, 0, 0); }
}
__device__ __forceinline__ s16x4 vtr(const LAS unsigned char* p) { typedef short v4i16_t __attribute__((ext_vector_type(4))); return __builtin_bit_cast(s16x4, __builtin_amdgcn_ds_read_tr16_b64_v4i16((LAS v4i16_t*)p)); }
template <int NKB, bool SWA>
__device__ __forceinline__ void attn_sub(const LAS unsigned char* lds, const bf16* Q, int qpitch, bf16* O, int kb0, int qpos0, bool first, float slope2, float sink2, int lane) {
    const int fr = lane & 15, fq = lane >> 4;
    bf16x8 qf[2];
#pragma unroll
    for (int ks = 0; ks < 2; ++ks) qf[ks] = *(const bf16x8*)(Q + (size_t)fr * qpitch + 32 * ks + 8 * fq);
    f32x4 s[NKB];
    const LAS unsigned char* kp = lds + AT_K + (16 * kb0 + fr) * 16 + fq * AT_KS;
#pragma unroll
    for (int jb = 0; jb < NKB; ++jb) {
        const bf16x8 k0 = *(const LAS bf16x8*)(kp + jb * 256), k1 = *(const LAS bf16x8*)(kp + jb * 256 + 4 * AT_KS);
        s[jb] = __builtin_amdgcn_mfma_f32_16x16x32_bf16(k0, qf[0], (f32x4){0.f, 0.f, 0.f, 0.f}, 0, 0, 0);
        s[jb] = __builtin_amdgcn_mfma_f32_16x16x32_bf16(k1, qf[1], s[jb], 0, 0, 0); }
    float mx = SWA ? sink2 : -3.0e38f;
#pragma unroll
    for (int jb = 0; jb < NKB; ++jb)
#pragma unroll
        for (int r = 0; r < 4; ++r) {
            if (SWA) { const int kpos = 16 * (kb0 + jb) + 4 * fq + r, dist = qpos0 + fr - kpos; const bool valid = (dist >= 0) && (dist < 128) && (!first || kpos >= 128);
                s[jb][r] = valid ? s[jb][r] - slope2 * (float)dist : -1.0e30f; }
            mx = fmaxf(mx, s[jb][r]); }
    mx = fmaxf(mx, __shfl_xor(mx, 16)); mx = fmaxf(mx, __shfl_xor(mx, 32));
    float l = 0.f;
#pragma unroll
    for (int jb = 0; jb < NKB; ++jb)
#pragma unroll
        for (int r = 0; r < 4; ++r) { const float p = __builtin_amdgcn_exp2f(s[jb][r] - mx); s[jb][r] = p; l += p; }
    l += __shfl_xor(l, 16); l += __shfl_xor(l, 32);
    if (SWA) l += __builtin_amdgcn_exp2f(sink2 - mx);
    const float rl = 1.0f / l;
    f32x4 o[4];
#pragma unroll
    for (int db = 0; db < 4; ++db) o[db] = (f32x4){0.f, 0.f, 0.f, 0.f};
    const LAS unsigned char* vp = lds + AT_V + (16 * kb0 + 4 * fq + (fr >> 2)) * 32 + (fr & 3) * 8;
#pragma unroll
    for (int kk = 0; kk < NKB / 2; ++kk) {
        u32x4 pw; pw.x = cvt_pk_bf16(s[2 * kk][0], s[2 * kk][1]); pw.y = cvt_pk_bf16(s[2 * kk][2], s[2 * kk][3]); pw.z = cvt_pk_bf16(s[2 * kk + 1][0], s[2 * kk + 1][1]); pw.w = cvt_pk_bf16(s[2 * kk + 1][2], s[2 * kk + 1][3]);
        const bf16x8 pf = __builtin_bit_cast(bf16x8, pw);
        const LAS unsigned char* va = vp + (2 * kk) * 512;
        const LAS unsigned char* vb = va + 512;
#pragma unroll
        for (int db = 0; db < 4; ++db) { const s16x4 lo = vtr(va + db * AT_VS), hi = vtr(vb + db * AT_VS);
            const bf16x8 vf = (bf16x8){lo[0], lo[1], lo[2], lo[3], hi[0], hi[1], hi[2], hi[3]};
            o[db] = __builtin_amdgcn_mfma_f32_16x16x32_bf16(vf, pf, o[db], 0, 0, 0); }
    }
#pragma unroll
    for (int db = 0; db < 4; ++db) { u32x2 w; w.x = cvt_pk_bf16(o[db][0] * rl, o[db][1] * rl); w.y = cvt_pk_bf16(o[db][2] * rl, o[db][3] * rl);
        *(u32x2*)(O + (size_t)fr * D + 16 * db + 4 * fq) = w; }
}
__device__ __forceinline__ void memattn_unit(Frame& F, const bf16* QM, const bf16* MK, const bf16* MV, bf16* MIX, int u) {
    const int b = u >> 7, rem = u & 127, qblk = rem >> 2, mh = rem & 3;
    __syncthreads();
    attn_load_kv(F, MK, MV, 256, b * MEM_LEN, b * MEM_LEN + 128, mh * HD);
    VM_WAIT(); __syncthreads();
#pragma unroll 1
    for (int i = 0; i < 2; ++i) { const int q0 = b * SEQ + qblk * 256 + 16 * (F.wave + 8 * i);
        attn_sub<16, false>(F.lds, QM + (size_t)q0 * 256 + mh * HD, 256, MIX + (size_t)q0 * D + 768 + mh * HD, 0, 0, false, 0.f, 0.f, F.lane); }
}
__device__ __forceinline__ void swa_unit(Frame& F, const bf16* Q, const bf16* Kb, const bf16* Vb, bf16* MIX, const float* sinks, int u) {
    const int b = u >> 8, rem = u & 255, n = rem >> 2, kvh = rem & 3;
    const int rowB = b * SEQ + n * 128, rowA = n > 0 ? rowB - 128 : rowB;
    __syncthreads();
    attn_load_kv(F, Kb, Vb, 256, rowA, rowB, kvh * HD);
    VM_WAIT(); __syncthreads();
#pragma unroll 1
    for (int g = 0; g < 3; ++g) { const int h = kvh * 3 + g, a = F.wave, q0 = rowB + 16 * a;
        const float slope2 = __builtin_amdgcn_exp2f(-8.0f * (float)(h + 1) / 12.0f) * LOG2E, sink2 = sinks[h] * LOG2E;
        attn_sub<10, true>(F.lds, Q + (size_t)q0 * 768 + h * HD, 768, MIX + (size_t)q0 * D + h * HD, a, 128 + 16 * a, n == 0, slope2, sink2, F.lane); }
}

__device__ __forceinline__ void router_phase(Frame& F, const Args& A, const bool dummy) {
    unsigned char* ws = F.ws + (dummy ? MiB : 0); const int lane = F.lane, w = F.wave; const int cw = CW_CNT + (dummy ? 2048 : 0);
    const float* g = A.in[I_SW_FFN_NORM_G]; const float* R = A.in[I_SW_ROUTER];
    int* tok_e = (int*)(ws + RT_TOKE); int* tok_s = (int*)(ws + RT_TOKS); float* tok_w = (float*)(ws + RT_TOKW);
    unsigned* XN8 = (unsigned*)(F.ws + WS_XN8 + (dummy ? 17 * MiB : 0));
    LAS int* le = (LAS int*)F.lds; LAS float* lw = (LAS float*)(F.lds + 512);
    float gr[4][4][8];
#pragma unroll
    for (int j = 0; j < 4; ++j)
#pragma unroll
        for (int jj = 0; jj < 4; ++jj) { const int k = 4 * lane + 256 * j + jj; const float gk = g[k]; const f32x4 r0 = *(const f32x4*)(R + k * 8), r1 = *(const f32x4*)(R + k * 8 + 4);
#pragma unroll
            for (int e = 0; e < 4; ++e) { gr[j][jj][e] = gk * r0[e]; gr[j][jj][4 + e] = gk * r1[e]; } }
    for (int tb = blockIdx.x; tb < M / 64; tb += F.G) {
        __syncthreads();
#pragma unroll 2
        for (int i = 0; i < 8; ++i) { const int tl = w * 8 + i, t = tb * 64 + tl;
            const f32x4* xr = (const f32x4*)(F.out + (size_t)t * D) + lane;
            float ss = 0.f, lg[8]; f32x4 x[4];
#pragma unroll
            for (int e = 0; e < 8; ++e) lg[e] = 0.f;
#pragma unroll
            for (int j = 0; j < 4; ++j) x[j] = xr[64 * j];
#pragma unroll
            for (int j = 0; j < 4; ++j)
#pragma unroll
                for (int jj = 0; jj < 4; ++jj) { ss = fmaf(x[j][jj], x[j][jj], ss);
#pragma unroll
                    for (int e = 0; e < 8; ++e) lg[e] = fmaf(x[j][jj], gr[j][jj][e], lg[e]); }
            ss = wave_sum(ss);
#pragma unroll
            for (int e = 0; e < 8; ++e) lg[e] = wave_sum(lg[e]);
            const float rstd = rsqrtf(ss * (1.0f / D) + RMS_EPS), sc = rstd * S_X;
#pragma unroll
            for (int j = 0; j < 4; ++j) XN8[(size_t)t * (D / 4) + lane + 64 * j] = pk4_fp8(x[j][0] * sc, x[j][1] * sc, x[j][2] * sc, x[j][3] * sc);
            int e1 = 0; float v1 = lg[0];
#pragma unroll
            for (int e = 1; e < 8; ++e) if (lg[e] > v1) { v1 = lg[e]; e1 = e; }
            int e2 = -1; float v2 = -3.0e38f;
#pragma unroll
            for (int e = 0; e < 8; ++e) if (e != e1 && lg[e] > v2) { v2 = lg[e]; e2 = e; }
            const float w1 = 1.0f / (1.0f + __expf((v2 - v1) * rstd)), w2 = 1.0f - w1;
            if (lane == 0) { le[tl] = e1; le[64 + tl] = e2; lw[tl] = w1; lw[64 + tl] = w2; }
        }
        __syncthreads();
        if (w == 0) { const int t = tb * 64 + lane; const int ea = le[lane], eb = le[64 + lane];
            unsigned mycnt = 0u; int rank_a = 0, rank_b = 0; const unsigned long long lt = (1ull << lane) - 1ull;
#pragma unroll
            for (int ee = 0; ee < 8; ++ee) { const unsigned long long ma = __ballot(ea == ee), mb = __ballot(eb == ee);
                if (lane == ee) mycnt = (unsigned)__popcll(ma); if (lane == 8 + ee) mycnt = (unsigned)__popcll(mb);
                if (ea == ee) rank_a = __popcll(ma & lt); if (eb == ee) rank_b = __popcll(mb & lt); }
            unsigned base = 0u; if (lane < 16 && mycnt) base = __hip_atomic_fetch_add(F.ctl + cw + lane * 64, mycnt, RLX_AGENT);
            const int ba = __shfl((int)base, ea), bb = __shfl((int)base, 8 + eb);
            tok_e[t] = ea; tok_s[t] = ba + rank_a; tok_w[t] = lw[lane];
            tok_e[M + t] = eb; tok_s[M + t] = bb + rank_b; tok_w[M + t] = lw[64 + lane]; }
    }
}
__device__ __forceinline__ void gather_phase(Frame& F) {
    unsigned char* ws = F.ws; const int lane = F.lane;
    LAS int* L = (LAS int*)F.lds;
    __syncthreads();
    if (F.tid == 0) { int o0 = 0, o1 = 0;
        for (int e = 0; e < 8; ++e) { const int c0 = (int)__hip_atomic_load(F.ctl + CW_CNT + e * 64, RLX_AGENT), c1 = (int)__hip_atomic_load(F.ctl + CW_CNT + (8 + e) * 64, RLX_AGENT);
            const int f1 = c1 & ~255, n0 = c0 + (c1 & 255); L[e] = o0; L[8 + e] = c0; L[16 + e] = o1; L[24 + e] = f1; o0 += (n0 + 255) & ~255; L[32 + e] = o0; o1 += f1; } }
    __syncthreads();
    const int* tok_e = (const int*)(ws + RT_TOKE); const int* tok_s = (const int*)(ws + RT_TOKS); const float* tok_w = (const float*)(ws + RT_TOKW);
    int* rowtok = (int*)(ws + RT_ROWTOK); float* rowg = (float*)(ws + RT_ROWG);
    unsigned char* XS = ws + WS_XS;
    const int gw = blockIdx.x * NWAVES + F.wave, NGW = F.G * NWAVES;
    for (int idx = gw; idx < 2 * M; idx += NGW) { const int p = idx / M, t = idx % M; const int e1 = tok_e[M + t], s1 = tok_s[M + t]; const bool left = s1 >= L[24 + e1];
        int r;
        if (p == 0) { const int e0 = tok_e[t]; r = L[e0] + tok_s[t]; }
        else r = left ? L[e1] + L[8 + e1] + (s1 - L[24 + e1]) : P0_ROWS + L[16 + e1] + s1;
        *((u32x4*)(XS + (size_t)r * D) + lane) = *((const u32x4*)(ws + WS_XN8 + (size_t)t * D) + lane);
        if (lane == 0) { rowtok[r] = t | (left ? TOK_ATOMIC : 0); rowg[r] = tok_w[idx]; } }
    for (int idx = gw; idx < 8 * 256; idx += NGW) { const int e = idx >> 8, j = idx & 255; const int r = L[e] + L[8 + e] + ((int)__hip_atomic_load(F.ctl + CW_CNT + (8 + e) * 64, RLX_AGENT) & 255) + j;
        if (r < L[32 + e]) { unsigned* dst = (unsigned*)(XS + (size_t)r * D) + lane;
#pragma unroll
            for (int q = 0; q < 4; ++q) dst[64 * q] = 0u;
            if (lane == 0) { rowtok[r] = -1; rowg[r] = 0.f; } } }
}

constexpr int N_PHASES = 14;
__global__ void __launch_bounds__(NWAVES * 64, 2) fwd_kernel(const Args A) {
    extern __shared__ __attribute__((aligned(16))) unsigned char lds_raw[];
    Frame F;
    F.lds = (LAS unsigned char*)lds_raw;
    F.MISC = (volatile LAS unsigned*)(F.lds + MISC_OFF);
    F.tid = threadIdx.x; F.lane = F.tid & 63; F.wave = __builtin_amdgcn_readfirstlane(F.tid >> 6);
    F.G = gridDim.x; F.ws = A.ws; F.out = A.out;
    unsigned char* ws = A.ws;
    F.ctl = (gu32*)(ws + WS_CTL);
    for (int u = F.tid; u < (LDS_BYTES - LDSCTL_OFF) / 4; u += NWAVES * 64) ((LAS unsigned*)(F.lds + LDSCTL_OFF))[u] = 0u;
    __syncthreads();
    XcdBarrier bar; bar.bar = (unsigned*)(F.ctl + CW_BAR); bar.x = 0; bar.st = nullptr;
    if (!MK_PER_PHASE) bar = xcd_barrier_post((unsigned*)(F.ctl + CW_BAR), F.MISC + 8);
    const int lo = A.ph_lo, hi = A.ph_hi;
#define IN(k) (lo <= (k) && (k) < hi)
#define PH(k, ...) if (IN(k)) { constexpr bool second_ = false; (void)second_; __VA_ARGS__ } if ((((PROBE_REPEAT_MASK) >> (k)) & 1) && IN(k)) { constexpr bool second_ = true; (void)second_; xcd_barrier(bar); __VA_ARGS__ }
#define SEAM(k) do { if (IN(k) && IN((k) + 1)) { if (MK_PER_PHASE) { if (F.tid == 0) __hip_atomic_store(F.ctl + CW_TMO, 0xBADBA0u | (unsigned)(k), RLX_AGENT); } else xcd_barrier(bar); } } while (0)
    const int c = (int)blockIdx.x;
    bf16* HB = (bf16*)(ws + WS_HB); float* H = (float*)(ws + WS_H); float* SSQ = (float*)(ws + WS_SSQ); bf16* MIX = (bf16*)(ws + WS_MIX);

    PH(0, p0_prologue(F, A);) SEAM(0);
    PH(1,
        Dense2Sched S{(const char*)HB, (const char*)(ws + WS_WIN0), M / 256, N_IN0 / 256, 2 * D, F.G, c, (const char*)(ws + WS_MEMB), (const char*)(ws + WS_WMKV)};
        EpiInProj0 E{SSQ, (const float*)(ws + WS_SSQM), A.in[I_CV_B_GLU], A.in[I_CV_MEMQ_NORM_G], A.in[I_MEM_K_NORM_G], (bf16*)(ws + PJ_U), (bf16*)(ws + PJ_QM0), (bf16*)(ws + WS_MEMK), (bf16*)(ws + WS_MEMV)};
        pg8::gemm_phase<EpiInProj0, Dense2Sched, true>(F.lds, 2 * D, S, E);
        steal_convert(F, A, 1);
    ) SEAM(1);
    PH(2,
        ConvCtx C;
        { const int ch = 2 * (F.tid < 384 ? F.tid : 0); const float* dw = A.in[I_CV_DW_W];
          _Pragma("unroll")
          for (int j = 0; j < CONV_W; ++j) { const f32x2 wv = *(const f32x2*)(dw + j * CONV_CH + ch); C.w0[j] = wv[0]; C.w1[j] = wv[1]; }
          C.b0 = A.in[I_CV_DW_B][ch]; C.b1 = A.in[I_CV_DW_B][ch + 1]; }
        for (int u = c; u < M / 16; u += F.G) conv_unit(F, C, (const bf16*)(ws + PJ_U), MIX, A.in[I_CV_LN_G], A.in[I_CV_LN_B], u);
        attn_zero_pads(F);
        for (int u = c; u < 256; u += F.G) memattn_unit(F, (const bf16*)(ws + PJ_QM0), (const bf16*)(ws + WS_MEMK), (const bf16*)(ws + WS_MEMV), MIX, u);
        __syncthreads();
    ) SEAM(2);
    PH(3,
        DenseSched S{(const char*)MIX, (const char*)(ws + WS_WOUT0), M / 256, D / 256, 2 * D, F.G, c};
        EpiResid E{A.in[I_X], H, HB, SSQ};
        pg8::gemm_phase<EpiResid, DenseSched, true>(F.lds, 2 * D, S, E);
    ) SEAM(3);
    PH(4,
        DenseSched S{(const char*)HB, (const char*)(ws + WS_WGU0), M / 256, 2 * FF / 256, 2 * D, F.G, c};
        EpiSwiglu E{SSQ, nullptr, (bf16*)(ws + WS_ACT0), FF};
        pg8::gemm_phase<EpiSwiglu, DenseSched, true>(F.lds, 2 * D, S, E);
        steal_convert(F, A, 4);
    ) SEAM(4);
    PH(5,
        DenseSched S{(const char*)(ws + WS_ACT0), (const char*)(ws + WS_WDN0), M / 256, D / 256, 2 * FF, F.G, c};
        EpiResid E{H, second_ ? (float*)(ws + 384 * MiB) : H, second_ ? (bf16*)(ws + WS_XS) : HB, second_ ? (float*)(ws + WS_ROUTE) : SSQ};
        pg8::gemm_phase<EpiResid, DenseSched, true>(F.lds, 2 * FF, S, E);
    ) SEAM(5);
    PH(6,
        DenseSched S{(const char*)HB, (const char*)(ws + WS_WIN1), M / 256, N_IN1 / 256, 2 * D, F.G, c};
        EpiInProj1 E{SSQ, A.in[I_SW_Q_NORM_G], A.in[I_SW_K_NORM_G], A.in[I_SW_MEMQ_NORM_G], (bf16*)(ws + PJ_Q), (bf16*)(ws + PJ_K), (bf16*)(ws + PJ_V), (bf16*)(ws + PJ_QM1)};
        pg8::gemm_phase<EpiInProj1, DenseSched, true>(F.lds, 2 * D, S, E);
        steal_convert(F, A, 6);
    ) SEAM(6);
    PH(7,
        attn_zero_pads(F);
        for (int u = c; u < 512; u += F.G) swa_unit(F, (const bf16*)(ws + PJ_Q), (const bf16*)(ws + PJ_K), (const bf16*)(ws + PJ_V), MIX, A.in[I_SW_SINKS], u);
        for (int u = c; u < 256; u += F.G) memattn_unit(F, (const bf16*)(ws + PJ_QM1), (const bf16*)(ws + WS_MEMK), (const bf16*)(ws + WS_MEMV), MIX, u);
        __syncthreads();
    ) SEAM(7);
    PH(8,
        DenseSched S{(const char*)MIX, (const char*)(ws + WS_WOUT1), M / 256, D / 256, 2 * D, F.G, c};
        EpiResid E{H, F.out, HB, SSQ};
        pg8::gemm_phase<EpiResid, DenseSched, true>(F.lds, 2 * D, S, E);
    ) SEAM(8);
    PH(9, if (!second_) steal_convert(F, A, -1); router_phase(F, A, second_);) SEAM(9);
    PH(10, gather_phase(F);) SEAM(10);
    const gu32* cntp = F.ctl + CW_CNT;
    PH(11, { MoeSched S; S.A = (const char*)(ws + WS_XS); S.W = (const char*)(ws + WS_WGUE); S.nN = 2 * FE / 256; S.KB = D; S.G = F.G; S.c = c; S.wstride = (size_t)2 * FE * D; S.init_counts(cntp, 0);
             EpiSwiglu8 E{ws + WS_ACTE}; pg8::gemm_phase<EpiSwiglu8, MoeSched, true, true>(F.lds, D, S, E); }) SEAM(11);
    PH(12, { { MoeSched S; S.A = (const char*)(ws + WS_ACTE); S.W = (const char*)(ws + WS_WDNE); S.nN = D / 256; S.KB = FE; S.G = F.G; S.c = c; S.wstride = (size_t)D * FE; S.init_counts(cntp, 0);
               EpiMoeDown E{(const int*)(ws + RT_ROWTOK), (const float*)(ws + RT_ROWG), F.out, second_ ? 0.0f : 1.0f}; pg8::gemm_phase<EpiMoeDown, MoeSched, true, true>(F.lds, FE, S, E); }
             __builtin_amdgcn_sched_barrier(0);
             { MoeSched S; S.init_counts(cntp, 0); const int nD = S.ts8 * 4;
               S.A = (const char*)(ws + WS_XS) + (size_t)P0_ROWS * D; S.W = (const char*)(ws + WS_WGUE); S.nN = 2 * FE / 256; S.KB = D; S.G = F.G; S.c = c; S.wstride = (size_t)2 * FE * D; S.init_counts(cntp, 1);
               S.x = nD % F.G; S.r0 = S.x ? 4 : 0;
               EpiSwiglu8 E{ws + WS_ACTE + (size_t)P0_ROWS * FE}; pg8::gemm_phase<EpiSwiglu8, MoeSched, true, true>(F.lds, D, S, E); } }) SEAM(12);
    PH(13, { MoeSched S; S.A = (const char*)(ws + WS_ACTE) + (size_t)P0_ROWS * FE; S.W = (const char*)(ws + WS_WDNE); S.nN = D / 256; S.KB = FE; S.G = F.G; S.c = c; S.wstride = (size_t)D * FE; S.init_counts(cntp, 1);
             EpiMoeDown E{(const int*)(ws + RT_ROWTOK) + P0_ROWS, (const float*)(ws + RT_ROWG) + P0_ROWS, F.out, second_ ? 0.0f : 1.0f}; pg8::gemm_phase<EpiMoeDown, MoeSched, true, true>(F.lds, FE, S, E); })
#undef IN
#undef SEAM
}

extern "C" void kernel_launch(void* const* d_in, const int* in_sizes, int n_in, void* d_out, int out_size, void* d_ws, size_t ws_size, hipStream_t stream) {
    static int grid = 0;
    if (grid == 0) {
        if (n_in != 30 || in_sizes[0] != M * D || out_size != M * D || ws_size < WS_END) { fprintf(stderr, "kernel_launch: unexpected shapes: n_in %d in0 %d out %d ws %zu (need %zu)\n", n_in, n_in > 0 ? in_sizes[0] : -1, out_size, ws_size, (size_t)WS_END); grid = -1; return; }
        int dev = 0, cus = 0, per_cu = 0;
        if (hipGetDevice(&dev) != hipSuccess || hipDeviceGetAttribute(&cus, hipDeviceAttributeMultiprocessorCount, dev) != hipSuccess) { grid = -1; return; }
        if (hipFuncSetAttribute((const void*)fwd_kernel, hipFuncAttributeMaxDynamicSharedMemorySize, LDS_BYTES) != hipSuccess) { fprintf(stderr, "kernel_launch: hipFuncSetAttribute failed\n"); grid = -1; return; }
        if (hipOccupancyMaxActiveBlocksPerMultiprocessor(&per_cu, (const void*)fwd_kernel, NWAVES * 64, LDS_BYTES) != hipSuccess || per_cu < 1) fprintf(stderr, "kernel_launch: occupancy query reports %d\n", per_cu);
        (void)hipGetLastError();
        grid = cus;
    }
    if (grid < 0) return;
    if (hipMemsetAsync((char*)d_ws + WS_CTL, 0, CTL_ZERO_BYTES, stream) != hipSuccess) return;
    Args a{};
    for (int i = 0; i < 30; ++i) a.in[i] = (const float*)d_in[i];
    a.out = (float*)d_out; a.ws = (unsigned char*)d_ws;
#if MK_PER_PHASE
    for (int p = 0; p < N_PHASES; ++p) { a.ph_lo = p; a.ph_hi = p + 1; hipLaunchKernelGGL(fwd_kernel, dim3(grid), dim3(NWAVES * 64), LDS_BYTES, stream, a); }
#else
    a.ph_lo = 0; a.ph_hi = N_PHASES;
    hipLaunchKernelGGL(fwd_kernel, dim3(grid), dim3(NWAVES * 64), LDS_BYTES, stream, a);
#endif
}
```
